# Optimizing an MI355X kernel written in HIP

```python
import jax, jax.numpy as jnp
from jax import lax
import numpy as np

D_MODEL = 2048
BATCH = 4
SEQ = 2048
DEPTH = 1

CONV_WIDTH = D_MODEL // 2
RET_WIDTH = D_MODEL - CONV_WIDTH
RET_HEADS = 4
RET_HEAD_DIM = RET_WIDTH // RET_HEADS
RET_CHUNK = 128
ROPE_BASE = 10000.0
CONV_KERNEL = 31
IN_PROJ_WIDTH = 2 * CONV_WIDTH + 4 * RET_WIDTH
N_EXPERTS = 32
TOP_K = 4
D_EXPERT = D_MODEL
SWIGLU_ALPHA = 1.702
SWIGLU_LIMIT = 7.0
MOE_BLOCK = 128
LN_EPS = 1e-5
DEEPNORM_ALPHA = float((2 * DEPTH) ** 0.25)
DEEPNORM_BETA = float((8 * DEPTH) ** -0.25)

kernel_name = "hymba_conformer_retnet_gptoss_deepnorm"


def _layer_norm(x, g, b):
    xf = x.astype(jnp.float32)
    mu = xf.mean(-1, keepdims=True)
    var = jnp.square(xf - mu).mean(-1, keepdims=True)
    return ((xf - mu) * lax.rsqrt(var + LN_EPS) * g + b).astype(x.dtype)


def _head_norm(r):
    mu = r.mean(-1, keepdims=True)
    var = jnp.square(r - mu).mean(-1, keepdims=True)
    return (r - mu) * lax.rsqrt(var + LN_EPS)


def _rotary(t):
    half = t.shape[-1] // 2
    inv_freq = ROPE_BASE ** (-jnp.arange(half, dtype=jnp.float32) / half)
    ang = jnp.arange(t.shape[1], dtype=jnp.float32)[:, None] * inv_freq[None, :]
    cos = jnp.cos(ang)[None, :, None, :]
    sin = jnp.sin(ang)[None, :, None, :]
    t = t.astype(jnp.float32)
    t1, t2 = t[..., :half], t[..., half:]
    return jnp.concatenate([t1 * cos - t2 * sin, t1 * sin + t2 * cos], axis=-1)


def _retention(q, k, v):
    bsz, s, h, dh = q.shape
    n_chunks = s // RET_CHUNK
    log_g = jnp.log(1.0 - 2.0 ** (-5.0 - jnp.arange(h, dtype=jnp.float32)))
    idx = jnp.arange(RET_CHUNK, dtype=jnp.float32)
    rel = idx[:, None] - idx[None, :]
    inner_decay = jnp.where(rel >= 0, jnp.exp(log_g[:, None, None] * jnp.maximum(rel, 0.0)), 0.0)
    q_decay = jnp.exp(log_g[:, None] * (idx[None, :] + 1.0))[None, :, :, None]
    k_decay = jnp.exp(log_g[:, None] * (RET_CHUNK - 1.0 - idx[None, :]))[None, :, :, None]
    chunk_decay = jnp.exp(log_g * RET_CHUNK)[None, :, None, None]

    def to_chunks(t):
        return t.reshape(bsz, n_chunks, RET_CHUNK, h, dh).transpose(1, 0, 3, 2, 4)

    def step(state, qkv):
        qi, ki, vi = qkv
        scores = jnp.einsum('bhcd,bhmd->bhcm', qi, ki) * inner_decay
        inner = jnp.einsum('bhcm,bhme->bhce', scores, vi)
        cross = jnp.einsum('bhcd,bhde->bhce', qi, state) * q_decay
        new_state = chunk_decay * state + jnp.einsum('bhmd,bhme->bhde', ki * k_decay, vi)
        return new_state, inner + cross

    state0 = jnp.zeros((bsz, h, dh, dh), jnp.float32)
    _, out = lax.scan(step, state0, (to_chunks(q), to_chunks(k), to_chunks(v)))
    return out.transpose(1, 0, 3, 2, 4).reshape(bsz, s, h, dh)


def _causal_depthwise_conv(u, w, b):
    out = lax.conv_general_dilated(
        u, w[:, None, :].astype(u.dtype), window_strides=(1,),
        padding=((CONV_KERNEL - 1, 0),), dimension_numbers=('NWC', 'WIO', 'NWC'),
        feature_group_count=u.shape[-1])
    return out + b


def _hybrid_mixer(h, w_in, b_in, conv_w, conv_b, conv_ln_g, conv_ln_b, w_out, b_out):
    bsz, s, _ = h.shape
    proj = h @ w_in + b_in
    cuts = [CONV_WIDTH, 2 * CONV_WIDTH, 2 * CONV_WIDTH + RET_WIDTH,
            2 * CONV_WIDTH + 2 * RET_WIDTH, 2 * CONV_WIDTH + 3 * RET_WIDTH]
    c_val, c_gate, q, k, v, g = jnp.split(proj, cuts, axis=-1)
    u = c_val * jax.nn.sigmoid(c_gate)
    u = _causal_depthwise_conv(u, conv_w, conv_b)
    u = jax.nn.silu(_layer_norm(u, conv_ln_g, conv_ln_b))
    heads = lambda t: t.reshape(bsz, s, RET_HEADS, RET_HEAD_DIM)
    qh = _rotary(heads(q))
    kh = _rotary(heads(k)) * (RET_HEAD_DIM ** -0.5)
    vh = heads(v).astype(jnp.float32)
    r = _head_norm(_retention(qh, kh, vh)).reshape(bsz, s, RET_WIDTH).astype(h.dtype)
    r = jax.nn.silu(g) * r
    return jnp.concatenate([u, r], axis=-1) @ w_out + b_out


def _moe(h, w_router, b_router, w_gate_up, b_gate_up, w_down, b_down):
    bsz, s, d = h.shape
    n_tok = bsz * s
    tok = h.reshape(n_tok, d)
    logits = (tok @ w_router + b_router).astype(jnp.float32)
    top_val, top_idx = lax.top_k(logits, TOP_K)
    gates = jax.nn.softmax(top_val, axis=-1)
    n_assign = n_tok * TOP_K
    flat_e = top_idx.reshape(n_assign)
    flat_tok = jnp.repeat(jnp.arange(n_tok, dtype=jnp.int32), TOP_K)
    flat_gate = gates.reshape(n_assign)
    order = jnp.argsort(flat_e)
    sorted_e = flat_e[order]
    counts = jnp.bincount(flat_e, length=N_EXPERTS)
    padded = ((counts + MOE_BLOCK - 1) // MOE_BLOCK) * MOE_BLOCK
    pad_end = jnp.cumsum(padded)
    pad_start = pad_end - padded
    grp_start = jnp.cumsum(counts) - counts
    dest = pad_start[sorted_e] + (jnp.arange(n_assign) - grp_start[sorted_e])
    n_rows = n_assign + N_EXPERTS * MOE_BLOCK
    n_blocks = n_rows // MOE_BLOCK
    row_tok = jnp.full((n_rows,), n_tok, jnp.int32).at[dest].set(flat_tok[order])
    row_gate = jnp.zeros((n_rows,), jnp.float32).at[dest].set(flat_gate[order])
    block_e = jnp.minimum(
        jnp.searchsorted(pad_end, jnp.arange(n_blocks) * MOE_BLOCK, side='right'), N_EXPERTS - 1)
    tok_pad = jnp.concatenate([tok, jnp.zeros((1, d), tok.dtype)], axis=0)
    xb = tok_pad[row_tok].reshape(n_blocks, MOE_BLOCK, d)

    def expert_block(args):
        xblk, e = args
        hgu = xblk @ w_gate_up[e] + b_gate_up[e]
        x_glu = jnp.minimum(hgu[:, :D_EXPERT], SWIGLU_LIMIT)
        x_lin = jnp.clip(hgu[:, D_EXPERT:], -SWIGLU_LIMIT, SWIGLU_LIMIT)
        act = x_glu * jax.nn.sigmoid(SWIGLU_ALPHA * x_glu) * (x_lin + 1.0)
        return act @ w_down[e] + b_down[e]

    yb = lax.map(expert_block, (xb, block_e)).reshape(n_rows, d)
    out = jnp.zeros((n_tok + 1, d), jnp.float32).at[row_tok].add(yb.astype(jnp.float32) * row_gate[:, None])
    return out[:n_tok].reshape(bsz, s, d).astype(h.dtype)


def setup_inputs(seed: int = 0) -> dict:
    key = jax.random.key(seed)
    ks = jax.random.split(key, 20)
    L, D, E, F = DEPTH, D_MODEL, N_EXPERTS, D_EXPERT
    nrm = lambda k, shape, scale: jax.random.normal(k, shape, jnp.float32) * scale
    return {
        "x": nrm(ks[0], (BATCH, SEQ, D), 1.0),
        "w_in": nrm(ks[1], (L, D, IN_PROJ_WIDTH), D ** -0.5),
        "b_in": nrm(ks[2], (L, IN_PROJ_WIDTH), 0.01),
        "conv_w": nrm(ks[3], (L, CONV_KERNEL, CONV_WIDTH), CONV_KERNEL ** -0.5),
        "conv_b": nrm(ks[4], (L, CONV_WIDTH), 0.01),
        "conv_ln_g": 1.0 + nrm(ks[5], (L, CONV_WIDTH), 0.02),
        "conv_ln_b": nrm(ks[6], (L, CONV_WIDTH), 0.01),
        "w_out": nrm(ks[7], (L, D, D), DEEPNORM_BETA * D ** -0.5),
        "b_out": nrm(ks[8], (L, D), 0.01),
        "ln1_g": 1.0 + nrm(ks[9], (L, D), 0.02),
        "ln1_b": nrm(ks[10], (L, D), 0.01),
        "w_router": nrm(ks[11], (L, D, E), D ** -0.5),
        "b_router": nrm(ks[12], (L, E), 0.01),
        "w_gate_up": nrm(ks[13], (L, E, D, 2 * F), D ** -0.5),
        "b_gate_up": nrm(ks[14], (L, E, 2 * F), 0.01),
        "w_down": nrm(ks[15], (L, E, F, D), DEEPNORM_BETA * F ** -0.5),
        "b_down": nrm(ks[16], (L, E, D), 0.01),
        "ln2_g": 1.0 + nrm(ks[17], (L, D), 0.02),
        "ln2_b": nrm(ks[18], (L, D), 0.01),
    }


def reference(x, w_in, b_in, conv_w, conv_b, conv_ln_g, conv_ln_b, w_out, b_out, ln1_g, ln1_b,
              w_router, b_router, w_gate_up, b_gate_up, w_down, b_down, ln2_g, ln2_b):
    h = x
    for l in range(DEPTH):
        mix = _hybrid_mixer(h, w_in[l], b_in[l], conv_w[l], conv_b[l], conv_ln_g[l], conv_ln_b[l],
                            w_out[l], b_out[l])
        h = _layer_norm(DEEPNORM_ALPHA * h + mix, ln1_g[l], ln1_b[l])
        ffn = _moe(h, w_router[l], b_router[l], w_gate_up[l], b_gate_up[l], w_down[l], b_down[l])
        h = _layer_norm(DEEPNORM_ALPHA * h + ffn, ln2_g[l], ln2_b[l])
    return h
```

```cpp
#include <hip/hip_runtime.h>
#include <cstdio>
#include <cstdint>

#ifndef MK_N_LAUNCHES
#define MK_N_LAUNCHES 1
#endif
#ifndef PROBE_DUP
#define PROBE_DUP -1
#endif

#define GAS __attribute__((address_space(1)))
#define LAS __attribute__((address_space(3)))
typedef unsigned short bf16_t;
typedef short bf16x8 __attribute__((ext_vector_type(8)));
typedef short bf16x4 __attribute__((ext_vector_type(4)));
typedef float f32x4 __attribute__((ext_vector_type(4)));
typedef float f32x2 __attribute__((ext_vector_type(2)));
typedef unsigned u32x4 __attribute__((ext_vector_type(4)));
typedef unsigned u32x2 __attribute__((ext_vector_type(2)));
typedef int v4i_t __attribute__((ext_vector_type(4)));
typedef int v8i_t __attribute__((ext_vector_type(8)));

constexpr int D = 2048, NTOK = 8192, SEQ = 2048, CW = 1024, NH = 4, HD = 256, NPROJ = 6144, NE = 32, TOPK = 4, FF = 2048, CK = 31;
constexpr int HROWS = 40960;
constexpr float LN_EPS = 1e-5f;
constexpr float DN_ALPHA = 1.189207115002721f;
constexpr int NPHASES = 8;
constexpr float WGU_SCALE = 32.0f, WD_SCALE = 64.0f;
constexpr int N_LAUNCHES = MK_N_LAUNCHES;

constexpr size_t MiB = 1u << 20;
constexpr size_t WS_CTL = 0, CTL_ZERO_BYTES = 1 * MiB;
constexpr size_t WS_ROWTOK = 1 * MiB;
constexpr size_t WS_ASSIGN = 2 * MiB;
constexpr size_t WS_ROPE = 3 * MiB;
constexpr size_t WS_WRT = 5 * MiB;
constexpr size_t WS_BIN = 6 * MiB, WS_BOUT = WS_BIN + 32768, WS_BGU = WS_BIN + 65536, WS_BDN = WS_BGU + 524288;
constexpr size_t WS_XT = 8 * MiB;
constexpr size_t WS_WIN = 40 * MiB;
constexpr size_t WS_WOUT = 64 * MiB;
constexpr size_t WS_UG = 72 * MiB;
constexpr size_t WS_Q = 88 * MiB;
constexpr size_t WS_K = 104 * MiB;
constexpr size_t WS_VT = 120 * MiB;
constexpr size_t WS_G = 136 * MiB;
constexpr size_t WS_CAT = 152 * MiB;
constexpr size_t WS_PRE1 = 184 * MiB;
constexpr size_t WS_HF = 248 * MiB;
constexpr size_t WS_HB = 312 * MiB;
constexpr size_t WS_HH = 344 * MiB;
constexpr size_t WS_Y = 504 * MiB;
constexpr size_t WS_WGU = 672 * MiB;
constexpr size_t WS_WD = 1184 * MiB;
constexpr size_t WS_END = 1440 * MiB;
constexpr int CW_CNT = 64;
constexpr int CW_BAR = 4096;

constexpr int LDS_BYTES = 163840;
constexpr int LDSCTL_OFF = 159744;
constexpr int TS_OFF = LDSCTL_OFF + 256;

#define LDS_WAIT() asm volatile("s_waitcnt lgkmcnt(0)" ::: "memory")
#define VM_WAIT() asm volatile("s_waitcnt vmcnt(0)" ::: "memory")
#define SBAR() __builtin_amdgcn_s_barrier()

__device__ __forceinline__ unsigned cvt_pk_bf16(float lo, float hi) { unsigned r; asm volatile("v_cvt_pk_bf16_f32 %0, %1, %2" : "=v"(r) : "v"(lo), "v"(hi)); return r; }
__device__ __forceinline__ float bf_lo(unsigned u) { return __builtin_bit_cast(float, u << 16); }
__device__ __forceinline__ float bf_hi(unsigned u) { return __builtin_bit_cast(float, u & 0xffff0000u); }
__device__ __forceinline__ float wave_sum(float v) {
#pragma unroll
    for (int o = 1; o < 64; o <<= 1) v += __shfl_xor(v, o);
    return v;
}
__device__ __forceinline__ int lane_id_opaque() { int l; asm volatile("v_mbcnt_lo_u32_b32 %0, -1, 0\n\tv_mbcnt_hi_u32_b32 %0, -1, %0" : "=v"(l)); return l; }
__device__ __forceinline__ float sigmoidf_(float x) { return __builtin_amdgcn_rcpf(1.0f + __builtin_amdgcn_exp2f(-1.4426950408889634f * x)); }

typedef __amdgpu_buffer_rsrc_t rsrc_t;
__device__ __forceinline__ u32x4 bld128(rsrc_t r, unsigned voff, unsigned soff) { return __builtin_amdgcn_raw_buffer_load_b128(r, (int)voff, (int)soff, 0); }
__device__ __forceinline__ f32x4 bld128f(rsrc_t r, unsigned voff, unsigned soff) { return __builtin_bit_cast(f32x4, __builtin_amdgcn_raw_buffer_load_b128(r, (int)voff, (int)soff, 0)); }
__device__ __forceinline__ float bld32f(rsrc_t r, unsigned voff, unsigned soff) { return __builtin_bit_cast(float, __builtin_amdgcn_raw_buffer_load_b32(r, (int)voff, (int)soff, 0)); }
__device__ __forceinline__ void bst128(rsrc_t r, u32x4 v, unsigned voff, unsigned soff) { __builtin_amdgcn_raw_buffer_store_b128(v, r, (int)voff, (int)soff, 0); }
__device__ __forceinline__ f32x4 gld128f(const unsigned char* wp, unsigned voff, unsigned soff) { return *(const GAS f32x4*)((const GAS unsigned char*)(wp + soff) + voff); }
__device__ __forceinline__ float gld32f(const unsigned char* wp, unsigned voff, unsigned soff) { return *(const GAS float*)((const GAS unsigned char*)(wp + soff) + voff); }
__device__ __forceinline__ void gst128(unsigned char* wp, u32x4 v, unsigned voff, unsigned soff) { *(GAS u32x4*)((GAS unsigned char*)(wp + soff) + voff) = v; }
__device__ __forceinline__ void gst64(unsigned char* wp, u32x2 v, unsigned voff, unsigned soff) { *(GAS u32x2*)((GAS unsigned char*)(wp + soff) + voff) = v; }
__device__ __forceinline__ void bst64(rsrc_t r, u32x2 v, unsigned voff, unsigned soff) { __builtin_amdgcn_raw_buffer_store_b64(v, r, (int)voff, (int)soff, 0); }

namespace pg8 {
constexpr int BM = 256, BK = 64, HALF = 128, HTB = HALF * BK * 2, STAGE_BYTES = 8 * HTB;
__host__ __device__ __forceinline__ int lds_byte(int r, int c) { const int st = (r >> 4) * 2 + (c >> 5), rr = r & 15, cc = c & 31, ob = rr * 64 + cc * 2; return st * 1024 + (ob ^ (((ob >> 9) & 1) << 5)); }
__host__ __device__ __forceinline__ void stage_rc(int b, int& R, int& C) { const int st = b / 1024, sb = b % 1024, swz = sb ^ (((sb >> 9) & 1) << 5); R = (st >> 1) * 16 + swz / 64; C = (st & 1) * 32 + (swz % 64) / 2; }
__host__ __device__ __forceinline__ int perm32(int rho) { const int n = rho >> 4, i = rho & 15; return 8 * (i >> 2) + 4 * n + (i & 3); }
__host__ __device__ __forceinline__ int xcd_remap(int L, int nwg) { const int q = nwg / 8, r = nwg % 8, xcd = L % 8, off = L / 8; return (xcd < r ? xcd * (q + 1) : r * (q + 1) + (xcd - r) * q) + off; }

struct Unit { unsigned a, b0, b1; int kind, row0, col0, e; };

template <class Epi, class Sched, bool GATHER, bool FP8>
__device__ __forceinline__ void gemm_phase(LAS unsigned char* lds, const int wid, const Sched& S, const Epi& E, const __amdgpu_buffer_rsrc_t rs, const unsigned kstepA, const unsigned kstepB) {
    const int lane = lane_id_opaque(), tid = wid * 64 + lane, wr = wid >> 2, wc = wid & 3, fr = lane & 15, fq = lane >> 4;
    constexpr int nt = FP8 ? 16 : 32;
    int R0, C0, R1, C1; stage_rc(tid * 16, R0, C0); stage_rc(tid * 16 + 8192, R1, C1);
    const unsigned vB0 = (unsigned)(((R0 & ~31) + perm32(R0 & 31)) * 128 + C0 * 2), vB1 = (unsigned)(((R1 & ~31) + perm32(R1 & 31)) * 128 + C1 * 2);
    unsigned cA00, cA01, cA10, cA11;
    const unsigned ldsw = (unsigned)wid * 1024u;
    const int aoff = lds_byte(wr * 64 + fr, fq * 8), boff = lds_byte(wc * 32 + fr, fq * 8);
#define PG8_SA(b, h) (((b) * 2 + (h)) * HTB)
#define PG8_SB(b, h) ((4 + (b) * 2 + (h)) * HTB)
#define PG8_LD1(rs, bufoff, vo, so, i) __builtin_amdgcn_raw_ptr_buffer_load_lds(rs, (LAS unsigned*)(lds + (bufoff) + ldsw + (i) * 8192), 16, (int)(vo), (int)(so), 0, 0)
#define PG8_STAGE_B(bufoff, so) do { PG8_LD1(rs, bufoff, vB0, so, 0); PG8_LD1(rs, bufoff, vB1, so, 1); } while (0)
#define PG8_STAGE_A(bufoff, so, o0, o1) do { PG8_LD1(rs, bufoff, o0, so, 0); PG8_LD1(rs, bufoff, o1, so, 1); } while (0)
#define PG8_LDA(dst, b, h) do { _Pragma("unroll") for (int m = 0; m < 4; ++m) { const v4i_t _l = *(const LAS v4i_t*)(lds + PG8_SA(b, h) + aoff + m * 2048), _h = *(const LAS v4i_t*)(lds + PG8_SA(b, h) + aoff + m * 2048 + 1024); \
        dst[m] = __builtin_shufflevector(_l, _h, 0, 1, 2, 3, 4, 5, 6, 7); } } while (0)
#define PG8_LDB(dst, b, h) do { _Pragma("unroll") for (int n = 0; n < 2; ++n) { const v4i_t _l = *(const LAS v4i_t*)(lds + PG8_SB(b, h) + boff + n * 2048), _h = *(const LAS v4i_t*)(lds + PG8_SB(b, h) + boff + n * 2048 + 1024); \
        dst[n] = __builtin_shufflevector(_l, _h, 0, 1, 2, 3, 4, 5, 6, 7); } } while (0)
#define PG8_MMA(ai, bj, At, Bt) do { __builtin_amdgcn_s_setprio(1); _Pragma("unroll") for (int m = 0; m < 4; ++m) _Pragma("unroll") for (int n = 0; n < 2; ++n) { \
        if constexpr (FP8) { acc[ai][bj][m][n] = __builtin_amdgcn_mfma_scale_f32_16x16x128_f8f6f4(Bt[n], At[m], acc[ai][bj][m][n], 0, 0, 0, 0x7F7F7F7F, 0, 0x7F7F7F7F); } \
        else { acc[ai][bj][m][n] = __builtin_amdgcn_mfma_f32_16x16x32_bf16(__builtin_bit_cast(bf16x8, __builtin_shufflevector(Bt[n], Bt[n], 0, 1, 2, 3)), __builtin_bit_cast(bf16x8, __builtin_shufflevector(At[m], At[m], 0, 1, 2, 3)), acc[ai][bj][m][n], 0, 0, 0); \
               acc[ai][bj][m][n] = __builtin_amdgcn_mfma_f32_16x16x32_bf16(__builtin_bit_cast(bf16x8, __builtin_shufflevector(Bt[n], Bt[n], 4, 5, 6, 7)), __builtin_bit_cast(bf16x8, __builtin_shufflevector(At[m], At[m], 4, 5, 6, 7)), acc[ai][bj][m][n], 0, 0, 0); } } \
        __builtin_amdgcn_s_setprio(0); } while (0)
#define PG8_WAIT_V(n) asm volatile("s_waitcnt vmcnt(" #n ")" ::: "memory")
#define PG8_WAIT_L(n) asm volatile("s_waitcnt lgkmcnt(" #n ")" ::: "memory")
#define PG8_BAR __builtin_amdgcn_s_barrier()
#define PG8_SCHED __builtin_amdgcn_sched_barrier(0)
    Unit cur, nxt; int ui = 0;
    if (!S.next(0, cur)) return;
    if constexpr (GATHER) { S.prep(lds + STAGE_BYTES, tid); S.gather(lds + STAGE_BYTES, 0, R0, C0, R1, C1, cA00, cA01, cA10, cA11); }
    else { cA00 = (unsigned)(R0 * 128 + C0 * 2); cA01 = (unsigned)(R1 * 128 + C1 * 2); cA10 = cA00 + 16384u; cA11 = cA01 + 16384u; }
    f32x4 acc[2][2][4][2];
#pragma unroll
    for (int a = 0; a < 2; ++a)
#pragma unroll
        for (int b = 0; b < 2; ++b)
#pragma unroll
            for (int m = 0; m < 4; ++m)
#pragma unroll
                for (int n = 0; n < 2; ++n) acc[a][b][m][n] = (f32x4){0.f, 0.f, 0.f, 0.f};
    v8i_t At[4], B0[2], B1[2];
    unsigned cA = cur.a, cB0 = cur.b0, cB1 = cur.b1;
    PG8_STAGE_B(PG8_SB(0, 0), cB0); PG8_STAGE_B(PG8_SB(0, 1), cB1); PG8_STAGE_A(PG8_SA(0, 0), cA, cA00, cA01); PG8_STAGE_A(PG8_SA(0, 1), cA, cA10, cA11);
    if (wr == 1) PG8_BAR;
    PG8_WAIT_V(2); PG8_BAR;
    PG8_STAGE_B(PG8_SB(1, 0), cB0 + kstepB); PG8_STAGE_A(PG8_SA(1, 0), cA + kstepA, cA00, cA01); PG8_STAGE_B(PG8_SB(1, 1), cB1 + kstepB);
    PG8_WAIT_V(6); PG8_BAR;
    for (;;) {
        const bool has_next = S.next(ui + 1, nxt);
        const unsigned nA = has_next ? nxt.a : cA, nB0 = has_next ? nxt.b0 : cB0, nB1 = has_next ? nxt.b1 : cB1;
        for (int t = 0; t < nt; t += 2) {
            const bool last = (t == nt - 2);
            const unsigned a1 = cA + (unsigned)(t + 1) * kstepA;
            const unsigned a2 = last ? nA : cA + (unsigned)(t + 2) * kstepA;
            const unsigned b02 = last ? nB0 : cB0 + (unsigned)(t + 2) * kstepB, b12 = last ? nB1 : cB1 + (unsigned)(t + 2) * kstepB;
            const unsigned a3 = a2 + kstepA, b03 = b02 + kstepB, b13 = b12 + kstepB;
            PG8_LDB(B0, 0, 0); PG8_LDB(B1, 0, 1); PG8_SCHED; PG8_LDA(At, 0, 0); PG8_STAGE_A(PG8_SA(1, 1), a1, cA10, cA11);
            PG8_WAIT_V(8); PG8_WAIT_L(0); PG8_BAR; PG8_MMA(0, 0, At, B0); PG8_MMA(0, 1, At, B1); PG8_BAR; PG8_SCHED;
            if constexpr (GATHER) { if (last && has_next) S.gather(lds + STAGE_BYTES, ui + 1, R0, C0, R1, C1, cA00, cA01, cA10, cA11); }
            PG8_LDA(At, 0, 1); PG8_STAGE_B(PG8_SB(0, 0), b02); PG8_STAGE_B(PG8_SB(0, 1), b12); PG8_STAGE_A(PG8_SA(0, 0), a2, cA00, cA01);
            PG8_WAIT_V(8); PG8_WAIT_L(0); PG8_BAR; PG8_MMA(1, 0, At, B0); PG8_MMA(1, 1, At, B1); PG8_BAR; PG8_SCHED;
            PG8_LDB(B0, 1, 0); PG8_LDB(B1, 1, 1); PG8_SCHED; PG8_LDA(At, 1, 0); PG8_STAGE_A(PG8_SA(0, 1), a2, cA10, cA11);
            PG8_WAIT_V(8); PG8_WAIT_L(0); PG8_BAR; PG8_MMA(0, 0, At, B0); PG8_MMA(0, 1, At, B1); PG8_BAR; PG8_SCHED;
            PG8_LDA(At, 1, 1); PG8_STAGE_B(PG8_SB(1, 0), b03); PG8_STAGE_B(PG8_SB(1, 1), b13); PG8_STAGE_A(PG8_SA(1, 0), a3, cA00, cA01);
            PG8_WAIT_V(8); PG8_WAIT_L(0); PG8_BAR; PG8_MMA(1, 0, At, B0); PG8_MMA(1, 1, At, B1); PG8_BAR; PG8_SCHED;
        }
        if (wr == 0) PG8_BAR;
        { const int lz = lane_id_opaque();
          E(acc, cur, wr, wc, lz & 15, lz >> 4); }
        if (!has_next) break;
#pragma unroll
        for (int a = 0; a < 2; ++a)
#pragma unroll
            for (int b = 0; b < 2; ++b)
#pragma unroll
                for (int m = 0; m < 4; ++m)
#pragma unroll
                    for (int n = 0; n < 2; ++n) acc[a][b][m][n] = (f32x4){0.f, 0.f, 0.f, 0.f};
        cur = nxt; cA = nA; cB0 = nB0; cB1 = nB1; ++ui;
        if (wr == 1) PG8_BAR;
    }
    PG8_WAIT_V(0);
    PG8_BAR;
#undef PG8_SA
#undef PG8_SB
#undef PG8_LD1
#undef PG8_STAGE_A
#undef PG8_STAGE_B
#undef PG8_LDA
#undef PG8_LDB
#undef PG8_MMA
#undef PG8_WAIT_V
#undef PG8_WAIT_L
#undef PG8_BAR
#undef PG8_SCHED
}
}

#define XB_TMO      128
#define XB_XCNT(j)  (256  + 64 * (j))
#define XB_XSUB(j)  (1280 + 64 * (j))
#define XB_XGEN(j)  (2304 + 64 * (j))
#define XB_TOP      3328
#define XB_TOPGEN   3392
#define XCD_BAR_WORDS 3456
#define XB_SPIN_CAP (1u << 18)
__device__ __forceinline__ unsigned xb_ld(unsigned* p)              { return __hip_atomic_load(p, __ATOMIC_RELAXED, __HIP_MEMORY_SCOPE_AGENT); }
__device__ __forceinline__ unsigned xb_add(unsigned* p, unsigned v) { return __hip_atomic_fetch_add(p, v, __ATOMIC_RELAXED, __HIP_MEMORY_SCOPE_AGENT); }
__device__ __forceinline__ unsigned xb_xcc_id() { return (unsigned)__builtin_amdgcn_s_getreg((3 << 11) | 20) & 0xFu; }
#define XB_SPIN(cond, bar) do { unsigned _sp = 0; while (cond) { __builtin_amdgcn_s_sleep(1); \
    if ((++_sp & 255u) == 0u) { if (xb_ld(&(bar)[XB_TMO])) break; if (_sp > XB_SPIN_CAP) { atomicAdd(&(bar)[XB_TMO], 1u); break; } } } } while (0)
struct XcdBarrier { unsigned* bar; unsigned x; volatile LAS unsigned* st; };
__device__ __forceinline__ XcdBarrier xcd_barrier_post(unsigned* bar, volatile LAS unsigned* st) {
    XcdBarrier b; b.bar = bar; b.x = xb_xcc_id(); b.st = st;
    if (threadIdx.x == 0) (void)xb_add(&bar[XB_XCNT(b.x)], 1u);
    return b;
}
__device__ __forceinline__ void xcd_barrier_complete(unsigned* bar, unsigned x, unsigned& nloc, unsigned& nx) {
    const unsigned G = gridDim.x * gridDim.y * gridDim.z;
    unsigned sum, cnt, mine, sp = 0u;
    for (;;) {
        sum = 0u; cnt = 0u; mine = 0u;
#pragma unroll
        for (unsigned j = 0; j < 16; ++j) { const unsigned c = xb_ld(&bar[XB_XCNT(j)]); sum += c; cnt += (c > 0u) ? 1u : 0u; mine = (j == x) ? c : mine; }
        if (sum == G) break;
        __builtin_amdgcn_s_sleep(1);
        if ((++sp & 255u) == 0u) { if (xb_ld(&bar[XB_TMO])) break; if (sp > XB_SPIN_CAP) { atomicAdd(&bar[XB_TMO], 1u); break; } }
    }
    nloc = mine > 0u ? mine : 1u; nx = cnt > 0u ? cnt : 1u;
}
__device__ __forceinline__ void xcd_barrier(const XcdBarrier& b, const int wave) {
    asm volatile("s_waitcnt vmcnt(0)" ::: "memory");
    __syncthreads();
    if (wave == 0 && lane_id_opaque() == 0) {
        unsigned* bar = b.bar;
        __builtin_amdgcn_s_waitcnt(0);
        unsigned nloc = b.st[0], nx = b.st[1];
        if (nloc == 0u) { xcd_barrier_complete(bar, b.x, nloc, nx); b.st[0] = nloc; b.st[1] = nx; }
        const unsigned old = xb_add(&bar[XB_XSUB(b.x)], 1u);
        const unsigned gen = old / nloc;
        if (old + 1u == (gen + 1u) * nloc) {
            __builtin_amdgcn_fence(__ATOMIC_RELEASE, "agent");
            asm volatile("s_waitcnt vmcnt(0)" ::: "memory");
            const unsigned og = xb_add(&bar[XB_TOP], 1u);
            const unsigned tg = og / nx;
            if (og + 1u == (tg + 1u) * nx) xb_add(&bar[XB_TOPGEN], 1u);
            else XB_SPIN(xb_ld(&bar[XB_TOPGEN]) == tg, bar);
            __builtin_amdgcn_fence(__ATOMIC_ACQUIRE, "agent");
            xb_add(&bar[XB_XGEN(b.x)], 1u);
            asm volatile("s_waitcnt vmcnt(0)" ::: "memory");
        } else {
            XB_SPIN(xb_ld(&bar[XB_XGEN(b.x)]) == gen, bar);
            __builtin_amdgcn_fence(__ATOMIC_ACQUIRE, "agent");
            asm volatile("s_waitcnt vmcnt(0)" ::: "memory");
        }
    }
    __syncthreads();
}

struct Frame {
    LAS unsigned char* lds;
    unsigned* ctl;
    int tid, lane, wave, vcu, G;
    const float *x, *w_in, *b_in, *conv_w, *conv_b, *conv_ln_g, *conv_ln_b, *w_out, *b_out, *ln1_g, *ln1_b, *w_router, *b_router, *w_gu, *b_gu, *w_down, *b_down, *ln2_g, *ln2_b;
    float* out;
    unsigned char* ws;
};
__device__ __forceinline__ size_t tiled8_idx(int nrows, int row, int col) { return ((size_t)(col >> 7) * nrows + row) * 128 + (col & 127); }
__device__ __forceinline__ size_t tiled_idx(int nrows, int row, int col) { return ((size_t)(col >> 6) * nrows + row) * 64 + (col & 63); }

__device__ __forceinline__ void p0_transpose_item(const float* W, int N, bf16_t* WT, LAS float* scr, int item, int lane) {
    const int nblk = N >> 6, kb = item / nblk, nb = item - kb * nblk, k0 = kb * 64, n0 = nb * 64;
    const int kr = lane >> 4, nq = lane & 15;
#pragma unroll
    for (int hh = 0; hh < 2; ++hh) {
        f32x4 v[8];
#pragma unroll
        for (int i = 0; i < 8; ++i) v[i] = *(const GAS f32x4*)(W + (size_t)(k0 + 32 * hh + 4 * i + kr) * N + n0 + 4 * nq);
#pragma unroll
        for (int i = 0; i < 8; ++i) { LAS float* s = scr + (32 * hh + 4 * i + kr) * 65 + 4 * nq; s[0] = v[i].x; s[1] = v[i].y; s[2] = v[i].z; s[3] = v[i].w; }
    }
    LDS_WAIT(); asm volatile("" ::: "memory");
    const int c = lane & 7;
#pragma unroll
    for (int j = 0; j < 8; ++j) { const int n = 8 * j + (lane >> 3); const LAS float* s = scr + (8 * c) * 65 + n;
        u32x4 o; o.x = cvt_pk_bf16(s[0 * 65], s[1 * 65]); o.y = cvt_pk_bf16(s[2 * 65], s[3 * 65]); o.z = cvt_pk_bf16(s[4 * 65], s[5 * 65]); o.w = cvt_pk_bf16(s[6 * 65], s[7 * 65]);
        *(GAS u32x4*)(WT + ((size_t)kb * N + n0 + n) * 64 + 8 * c) = o; }
    LDS_WAIT(); asm volatile("" ::: "memory");
}
constexpr int MOE_I_GU = 16 * (2 * FF / 64), MOE_I_DN = 16 * (D / 64), MOE_N_GU = NE * MOE_I_GU, MOE_N_ALL = MOE_N_GU + NE * MOE_I_DN;
__device__ __forceinline__ int moe_rounds(int G) { return (MOE_N_ALL + G * 8 - 1) / (G * 8); }
struct MoeItem { const float* W; unsigned char* WT; int N; float scale; };
__device__ __forceinline__ MoeItem moe_item(Frame& F, int j) {
    MoeItem m; int it = (j * F.G + F.vcu) * 8 + F.wave; if (it >= MOE_N_ALL) it -= MOE_N_ALL;
    if (it < MOE_N_GU) { const int e = it / MOE_I_GU, r = it - e * MOE_I_GU; const int nblk = (2 * FF) >> 6, kb = r / nblk, nb = r - kb * nblk; m.N = 2 * FF; m.scale = WGU_SCALE;
        m.W = F.w_gu + (size_t)e * D * 2 * FF + (size_t)(kb * 128) * (2 * FF) + nb * 64; m.WT = F.ws + WS_WGU + (size_t)e * D * 2 * FF + ((size_t)kb * (2 * FF) + nb * 64) * 128; }
    else { const int q = it - MOE_N_GU; const int e = q / MOE_I_DN, r = q - e * MOE_I_DN; const int nblk = D >> 6, kb = r / nblk, nb = r - kb * nblk; m.N = D; m.scale = WD_SCALE;
        m.W = F.w_down + (size_t)e * FF * D + (size_t)(kb * 128) * D + nb * 64; m.WT = F.ws + WS_WD + (size_t)e * FF * D + ((size_t)kb * D + nb * 64) * 128; }
    return m;
}
#define MOE_LOADS(m) do { _Pragma("unroll") for (int i = 0; i < 8; ++i) _Pragma("unroll") for (int jj = 0; jj < 4; ++jj) \
        v[i][jj] = __builtin_nontemporal_load((const GAS f32x4*)((m).W + (size_t)(16 * i + 4 * kq + jj) * (m).N + 4 * nq)); } while (0)
#define MOE_CVT(m) do { _Pragma("unroll") for (int i = 0; i < 8; ++i) _Pragma("unroll") for (int c = 0; c < 4; ++c) { \
        int p = __builtin_amdgcn_cvt_pk_fp8_f32(v[i][0][c] * (m).scale, v[i][1][c] * (m).scale, 0, false); p = __builtin_amdgcn_cvt_pk_fp8_f32(v[i][2][c] * (m).scale, v[i][3][c] * (m).scale, p, true); \
        *(LAS int*)(scr + (4 * nq + c) * 144 + 16 * i + 4 * kq) = p; } \
        LDS_WAIT(); asm volatile("" ::: "memory"); \
        _Pragma("unroll") for (int p = 0; p < 8; ++p) o[p] = *(const LAS u32x4*)(scr + (8 * p + (lane >> 3)) * 144 + 16 * (lane & 7)); \
        LDS_WAIT(); asm volatile("" ::: "memory"); } while (0)
#define MOE_STORES(m) do { _Pragma("unroll") for (int p = 0; p < 8; ++p) __builtin_nontemporal_store(o[p], (GAS u32x4*)((m).WT + (size_t)(8 * p + (lane >> 3)) * 128 + 16 * (lane & 7))); } while (0)
__device__ __forceinline__ void moe_convert(Frame& F, int j_lo, int j_hi) {
    if (j_lo < j_hi) {
        LAS unsigned char* scr = F.lds + F.wave * 9216;
        const int lane = F.lane, kq = lane >> 4, nq = lane & 15;
        f32x4 v[8][4]; u32x4 o[8];
        MoeItem cur = moe_item(F, j_lo);
        MOE_LOADS(cur);
        for (int j = j_lo; j + 1 < j_hi; ++j) {
            const MoeItem nxt = moe_item(F, j + 1);
            MOE_CVT(cur);
            MOE_LOADS(nxt);
            MOE_STORES(cur);
            cur = nxt;
        }
        MOE_CVT(cur);
        MOE_STORES(cur);
    }
    LDS_WAIT(); __syncthreads();
}
#undef MOE_LOADS
#undef MOE_CVT
#undef MOE_STORES
__device__ __forceinline__ void p0_prologue(Frame& F) {
    LAS float* scr = (LAS float*)(F.lds + F.wave * 16640);
    const int gw = F.vcu * 8 + F.wave, NGW = F.G * 8;
    constexpr int I_IN = 32 * (NPROJ / 64), I_OUT = 32 * (D / 64);
    constexpr int NITEMS = I_IN + I_OUT;
    for (int it = gw; it < NITEMS; it += NGW) {
        if (it < I_IN) p0_transpose_item(F.w_in, NPROJ, (bf16_t*)(F.ws + WS_WIN), scr, it, F.lane);
        else p0_transpose_item(F.w_out, D, (bf16_t*)(F.ws + WS_WOUT), scr, it - I_IN, F.lane);
    }
    bf16_t* XT = (bf16_t*)(F.ws + WS_XT);
    for (int m = gw; m < NTOK; m += NGW) {
        const GAS f32x4* xr = (const GAS f32x4*)(F.x + (size_t)m * D) + F.lane;
#pragma unroll
        for (int j = 0; j < 8; ++j) { const f32x4 v = xr[64 * j]; const int col = 256 * j + 4 * F.lane;
            u32x2 o; o.x = cvt_pk_bf16(v.x, v.y); o.y = cvt_pk_bf16(v.z, v.w); *(GAS u32x2*)(XT + tiled_idx(NTOK, m, col)) = o; }
    }
    float* COS = (float*)(F.ws + WS_ROPE); float* SIN = COS + SEQ * 128;
    for (int idx = (F.vcu * 512 + F.tid); idx < SEQ * 128; idx += F.G * 512) {
        const int pos = idx >> 7, i = idx & 127;
        const float invf = powf(10000.0f, -(float)i / 128.0f);
        const float angf = (float)pos * invf;
        const double a = (double)angf;
        const double n = __builtin_rint(a * 0.6366197723675814);
        const double r = __builtin_fma(-n, 6.123233995736766e-17, __builtin_fma(-n, 1.5707963267948966, a));
        const double r2 = r * r;
        double sp = -7.647163731819816e-13; sp = sp * r2 + 1.6059043836821613e-10; sp = sp * r2 - 2.505210838544172e-08; sp = sp * r2 + 2.7557319223985893e-06; sp = sp * r2 - 1.984126984126984e-04; sp = sp * r2 + 8.333333333333333e-03; sp = sp * r2 - 1.6666666666666666e-01;
        const double sr = r + r * r2 * sp;
        double cp = 4.779477332387385e-14; cp = cp * r2 - 1.1470745597729725e-11; cp = cp * r2 + 2.08767569878681e-09; cp = cp * r2 - 2.755731922398589e-07; cp = cp * r2 + 2.48015873015873e-05; cp = cp * r2 - 1.388888888888889e-03; cp = cp * r2 + 4.1666666666666664e-02; cp = cp * r2 - 0.5;
        const double cr = 1.0 + r2 * cp;
        const int q = ((int)n) & 3;
        const double sv = (q == 0) ? sr : (q == 1) ? cr : (q == 2) ? -sr : -cr;
        const double cv = (q == 0) ? cr : (q == 1) ? -sr : (q == 2) ? -cr : sr;
        COS[idx] = (float)cv; SIN[idx] = (float)sv;
    }
    for (int idx = (F.vcu * 512 + F.tid); idx < NPROJ + D + NE * 2 * FF + NE * D; idx += F.G * 512) {
        if (idx < NPROJ) ((float*)(F.ws + WS_BIN))[idx] = F.b_in[idx];
        else if (idx < NPROJ + D) ((float*)(F.ws + WS_BOUT))[idx - NPROJ] = F.b_out[idx - NPROJ];
        else if (idx < NPROJ + D + NE * 2 * FF) ((float*)(F.ws + WS_BGU))[idx - NPROJ - D] = F.b_gu[idx - NPROJ - D];
        else ((float*)(F.ws + WS_BDN))[idx - NPROJ - D - NE * 2 * FF] = F.b_down[idx - NPROJ - D - NE * 2 * FF];
    }
    float* WRT = (float*)(F.ws + WS_WRT);
    for (int idx = (F.vcu * 512 + F.tid); idx < D * NE; idx += F.G * 512) { const int k = idx >> 5, e = idx & 31; WRT[e * D + k] = F.w_router[idx]; }
}

struct InProjOrder {
    int G, c, r;
    __device__ __forceinline__ bool next(int i, pg8::Unit& u) const {
        if (i != 0) return false;
        const int L = r * G + c; if (L >= 640) return false;
        const int wgid = pg8::xcd_remap(L, 640);
        const int nig = 8 * 20, gid = wgid / nig, fm = gid * 8, pm = fm + ((wgid % nig) % 8), pn = (wgid % nig) / 8;
        u.a = (unsigned)WS_XT + (unsigned)(256 * pm) * 128u; u.row0 = 256 * pm;
        int c0, c1;
        if (pn < 8) { u.kind = 0; c0 = 128 * pn; c1 = 1024 + 128 * pn; u.col0 = 128 * pn; u.e = 0; }
        else if (pn < 12) { u.kind = 1; u.e = pn - 8; c0 = 2048 + 256 * u.e; c1 = c0 + 128; u.col0 = c0; }
        else if (pn < 16) { u.kind = 2; u.e = pn - 12; c0 = 3072 + 256 * u.e; c1 = c0 + 128; u.col0 = c0; }
        else { u.kind = 3; u.e = pn - 16; c0 = 5120 + 256 * u.e; c1 = c0 + 128; u.col0 = c0; }
        u.b0 = (unsigned)WS_WIN + (unsigned)c0 * 128u; u.b1 = (unsigned)WS_WIN + (unsigned)c1 * 128u;
        return true;
    }
};
struct InProjVtOrder {
    int c;
    __device__ __forceinline__ bool next(int i, pg8::Unit& u) const {
        if (i != 0 || c < 128) return false;
        const int L = c - 128, pm = L & 3, pn = L >> 2;
        u.a = (unsigned)WS_WIN + (unsigned)(4096 + 256 * pm) * 128u; u.row0 = 256 * pm; u.col0 = 256 * pn; u.kind = 4; u.e = 0;
        u.b0 = (unsigned)WS_XT + (unsigned)(256 * pn) * 128u; u.b1 = u.b0 + 128u * 128u;
        return true;
    }
};
struct EpiInProj {
    unsigned char* wp;
    __device__ __forceinline__ void operator()(const f32x4 (&acc)[2][2][4][2], const pg8::Unit& u, int wr, int wc, int fr, int fq) const {
        const int cr = wc * 32 + 8 * fq, lrow = wr * 64 + fr;
        if (u.kind == 0) {
            f32x4 bv[2][2];
#pragma unroll
            for (int bj = 0; bj < 2; ++bj)
#pragma unroll
                for (int n = 0; n < 2; ++n) bv[bj][n] = gld128f(wp, (unsigned)((u.col0 + cr) * 4 + n * 16), (unsigned)WS_BIN + bj * 4096u);
            const unsigned vo = (unsigned)((u.row0 + lrow) * 2048 + (u.col0 + cr) * 2);
#pragma unroll
            for (int ai = 0; ai < 2; ++ai)
#pragma unroll
                for (int m = 0; m < 4; ++m) {
                    float o[8];
#pragma unroll
                    for (int n = 0; n < 2; ++n)
#pragma unroll
                        for (int j = 0; j < 4; ++j) { const float v = acc[ai][0][m][n][j] + bv[0][n][j], g = acc[ai][1][m][n][j] + bv[1][n][j]; o[4 * n + j] = v * sigmoidf_(g); }
                    u32x4 w; w.x = cvt_pk_bf16(o[0], o[1]); w.y = cvt_pk_bf16(o[2], o[3]); w.z = cvt_pk_bf16(o[4], o[5]); w.w = cvt_pk_bf16(o[6], o[7]);
                    gst128(wp, w, vo, (unsigned)WS_UG + (unsigned)(ai * 128 + m * 16) * 2048u); }
        } else if (u.kind == 1 || u.kind == 2) {
            const int h = u.e; const unsigned obase = (u.kind == 1) ? (unsigned)WS_Q : (unsigned)WS_K;
            const float l2g = __log2f(1.0f - __builtin_amdgcn_exp2f(-5.0f - (float)h));
            f32x4 bv[2][2];
#pragma unroll
            for (int bj = 0; bj < 2; ++bj)
#pragma unroll
                for (int n = 0; n < 2; ++n) bv[bj][n] = gld128f(wp, (unsigned)((u.col0 + cr) * 4 + n * 16), (unsigned)WS_BIN + bj * 512u);
            const unsigned vrope = (unsigned)(((u.row0 & (SEQ - 1)) + lrow) * 512 + cr * 4);
            const unsigned vo = (unsigned)((((cr >> 6) * NTOK + lrow) + (4 * h * NTOK + u.row0)) * 128 + (cr & 63) * 2);
#pragma unroll
            for (int ai = 0; ai < 2; ++ai)
#pragma unroll
                for (int m = 0; m < 4; ++m) { const int a = 16 * m + fr;
                    const float sc = (u.kind == 1) ? __builtin_amdgcn_exp2f((float)(a + 1) * l2g) : 0.0625f * __builtin_amdgcn_exp2f((float)(63 - a) * l2g);
                    float o1[8], o2[8];
#pragma unroll
                    for (int n = 0; n < 2; ++n) { const f32x4 cs = gld128f(wp, vrope + n * 16, (unsigned)WS_ROPE + (unsigned)(ai * 128 + m * 16) * 512u), sn = gld128f(wp, vrope + n * 16, (unsigned)WS_ROPE + (unsigned)(SEQ * 128 * 4) + (unsigned)(ai * 128 + m * 16) * 512u);
#pragma unroll
                        for (int j = 0; j < 4; ++j) { const float t1 = acc[ai][0][m][n][j] + bv[0][n][j], t2 = acc[ai][1][m][n][j] + bv[1][n][j];
                            o1[4 * n + j] = (t1 * cs[j] - t2 * sn[j]) * sc; o2[4 * n + j] = (t1 * sn[j] + t2 * cs[j]) * sc; } }
                    u32x4 w1, w2; w1.x = cvt_pk_bf16(o1[0], o1[1]); w1.y = cvt_pk_bf16(o1[2], o1[3]); w1.z = cvt_pk_bf16(o1[4], o1[5]); w1.w = cvt_pk_bf16(o1[6], o1[7]);
                    w2.x = cvt_pk_bf16(o2[0], o2[1]); w2.y = cvt_pk_bf16(o2[2], o2[3]); w2.z = cvt_pk_bf16(o2[4], o2[5]); w2.w = cvt_pk_bf16(o2[6], o2[7]);
                    gst128(wp, w1, vo, obase + (unsigned)(ai * 128 + m * 16) * 128u); gst128(wp, w2, vo, obase + (unsigned)(ai * 128 + m * 16) * 128u + 2u * NTOK * 128u); }
        } else if (u.kind == 3) {
            const int h = u.e;
            f32x4 bv[2][2];
#pragma unroll
            for (int bj = 0; bj < 2; ++bj)
#pragma unroll
                for (int n = 0; n < 2; ++n) bv[bj][n] = gld128f(wp, (unsigned)((u.col0 + cr) * 4 + n * 16), (unsigned)WS_BIN + bj * 512u);
            const unsigned vo = (unsigned)((u.row0 + lrow) * 2048 + (256 * h + cr) * 2);
#pragma unroll
            for (int ai = 0; ai < 2; ++ai)
#pragma unroll
                for (int m = 0; m < 4; ++m) {
#pragma unroll
                    for (int bj = 0; bj < 2; ++bj) { float o[8];
#pragma unroll
                        for (int n = 0; n < 2; ++n)
#pragma unroll
                            for (int j = 0; j < 4; ++j) { const float g = acc[ai][bj][m][n][j] + bv[bj][n][j]; o[4 * n + j] = g * sigmoidf_(g); }
                        u32x4 w; w.x = cvt_pk_bf16(o[0], o[1]); w.y = cvt_pk_bf16(o[2], o[3]); w.z = cvt_pk_bf16(o[4], o[5]); w.w = cvt_pk_bf16(o[6], o[7]);
                        gst128(wp, w, vo, (unsigned)WS_G + (unsigned)(ai * 128 + m * 16) * 2048u + bj * 256u); } }
        } else {
            const unsigned vb = (unsigned)((4096 + u.row0 + lrow) * 4);
            const unsigned vo = (unsigned)((((cr >> 6) * 1024 + lrow) + ((u.col0 >> 6) * 1024 + u.row0)) * 128 + (cr & 63) * 2);
#pragma unroll
            for (int ai = 0; ai < 2; ++ai)
#pragma unroll
                for (int m = 0; m < 4; ++m) { const float bb = gld32f(wp, vb, (unsigned)WS_BIN + (unsigned)(ai * 128 + m * 16) * 4u);
#pragma unroll
                    for (int bj = 0; bj < 2; ++bj) {
                        const f32x4 v0 = acc[ai][bj][m][0] + bb, v1 = acc[ai][bj][m][1] + bb;
                        u32x4 w; w.x = cvt_pk_bf16(v0[0], v0[1]); w.y = cvt_pk_bf16(v0[2], v0[3]); w.z = cvt_pk_bf16(v1[0], v1[1]); w.w = cvt_pk_bf16(v1[2], v1[3]);
                        gst128(wp, w, vo, (unsigned)WS_VT + (unsigned)(ai * 128 + m * 16) * 128u + (unsigned)bj * 2u * 1024u * 128u); } }
        }
    }
};

__device__ __forceinline__ void conv_unit(Frame& F, int unit) {
    const int b = unit >> 6, t0 = (unit & 63) * 32;
    const bf16_t* UG = (const bf16_t*)(F.ws + WS_UG); bf16_t* CAT = (bf16_t*)(F.ws + WS_CAT);
    LAS unsigned char* in = F.lds; LAS float* stg = (LAS float*)(F.lds + 126976);
    for (int c = F.tid; c < 62 * 128; c += 512) { const int row = c >> 7, ch = c & 127, t = t0 - 30 + row;
        u32x4 v = (u32x4){0u, 0u, 0u, 0u};
        if (t >= 0) v = *(const GAS u32x4*)(UG + (size_t)(b * SEQ + t) * CW + ch * 8);
        *(LAS u32x4*)(in + row * 2048 + ch * 16) = v; }
    float w0[CK], w1[CK];
#pragma unroll
    for (int k = 0; k < CK; ++k) { const f32x2 w = *(const GAS f32x2*)(F.conv_w + k * CW + 2 * F.tid); w0[k] = w.x; w1[k] = w.y; }
    const f32x2 cb = *(const GAS f32x2*)(F.conv_b + 2 * F.tid);
    f32x4 lg[4], lb[4];
#pragma unroll
    for (int j = 0; j < 4; ++j) { lg[j] = *(const GAS f32x4*)(F.conv_ln_g + 256 * j + 4 * F.lane); lb[j] = *(const GAS f32x4*)(F.conv_ln_b + 256 * j + 4 * F.lane); }
    LDS_WAIT(); __syncthreads();
    for (int blk = 0; blk < 4; ++blk) {
        float a0[8], a1[8];
#pragma unroll
        for (int tt = 0; tt < 8; ++tt) { a0[tt] = cb.x; a1[tt] = cb.y; }
#pragma unroll
        for (int rr = 0; rr < 38; ++rr) { const unsigned xv = *(const LAS unsigned*)(in + (8 * blk + rr) * 2048 + 4 * F.tid); const float x0 = bf_lo(xv), x1 = bf_hi(xv);
#pragma unroll
            for (int tt = 0; tt < 8; ++tt) { const int k = rr - tt; if (k >= 0 && k < CK) { a0[tt] += w0[k] * x0; a1[tt] += w1[k] * x1; } } }
#pragma unroll
        for (int tt = 0; tt < 8; ++tt) *(LAS f32x2*)(stg + tt * 1024 + 2 * F.tid) = (f32x2){a0[tt], a1[tt]};
        LDS_WAIT(); __syncthreads();
        {
            const int row = b * SEQ + t0 + 8 * blk + F.wave;
            f32x4 v[4]; float s = 0.f;
#pragma unroll
            for (int j = 0; j < 4; ++j) { v[j] = *(const LAS f32x4*)(stg + F.wave * 1024 + 256 * j + 4 * F.lane); s += (v[j].x + v[j].y) + (v[j].z + v[j].w); }
            const float mean = wave_sum(s) * (1.f / CW); float s2 = 0.f;
#pragma unroll
            for (int j = 0; j < 4; ++j) { v[j] = v[j] - mean; s2 += (v[j].x * v[j].x + v[j].y * v[j].y) + (v[j].z * v[j].z + v[j].w * v[j].w); }
            const float rstd = 1.0f / sqrtf(wave_sum(s2) * (1.f / CW) + LN_EPS);
#pragma unroll
            for (int j = 0; j < 4; ++j) { f32x4 y = v[j] * rstd * lg[j] + lb[j];
                y.x = y.x * sigmoidf_(y.x); y.y = y.y * sigmoidf_(y.y); y.z = y.z * sigmoidf_(y.z); y.w = y.w * sigmoidf_(y.w);
                u32x2 o; o.x = cvt_pk_bf16(y.x, y.y); o.y = cvt_pk_bf16(y.z, y.w);
                *(GAS u32x2*)(CAT + tiled_idx(NTOK, row, 256 * j + 4 * F.lane)) = o; }
        }
        LDS_WAIT(); __syncthreads();
    }
}

__device__ __forceinline__ void ret_unit(Frame& F, int unit) {
    using namespace pg8;
    const int bh = unit >> 4, b = bh >> 2, h = bh & 3, p = unit & 15;
    const bf16_t* Qt = (const bf16_t*)(F.ws + WS_Q); const bf16_t* Kt = (const bf16_t*)(F.ws + WS_K); const bf16_t* VT = (const bf16_t*)(F.ws + WS_VT);
    const bf16_t* Gp = (const bf16_t*)(F.ws + WS_G); bf16_t* CAT = (bf16_t*)(F.ws + WS_CAT);
    const int tid = F.tid, lane = F.lane, wid = F.wave, wq = wid >> 1, wk = wid & 1, fr = lane & 15, fq = lane >> 4;
    LAS unsigned char* lds = F.lds;
    const float l2g = __log2f(1.0f - __builtin_amdgcn_exp2f(-5.0f - (float)h));
    int R0, C0, R1, C1; stage_rc(tid * 16, R0, C0); stage_rc(tid * 16 + 8192, R1, C1);
    const unsigned ldsw = (unsigned)wid * 1024u;
    for (int pass = 0; pass < 2; ++pass) {
        const int qb = pass ? p : 31 - p;
        const int tok0 = b * SEQ + 64 * qb;
        bf16x8 qf[8];
#pragma unroll
        for (int ks = 0; ks < 8; ++ks) qf[ks] = *(const GAS bf16x8*)(Qt + tiled_idx(NTOK, tok0 + 16 * wq + fr, 256 * h + 32 * ks + 8 * fq));
        f32x4 o[16];
#pragma unroll
        for (int dt = 0; dt < 16; ++dt) o[dt] = (f32x4){0.f, 0.f, 0.f, 0.f};
#define RET_ISSUE(j) do { const int _buf = ((j) & 1) * 65536; const int _key0 = b * SEQ + 64 * (j); \
        _Pragma("unroll") for (int c = 0; c < 4; ++c) __builtin_amdgcn_global_load_lds((const unsigned*)(Kt + ((size_t)(4 * h + c) * NTOK + _key0 + R0) * 64 + C0), (LAS unsigned*)(lds + _buf + c * 8192 + ldsw), 16, 0, 0); \
        _Pragma("unroll") for (int hh = 0; hh < 2; ++hh) { \
            __builtin_amdgcn_global_load_lds((const unsigned*)(VT + ((size_t)(_key0 >> 6) * 1024 + 256 * h + 128 * hh + R0) * 64 + C0), (LAS unsigned*)(lds + _buf + 32768 + hh * 16384 + ldsw), 16, 0, 0); \
            __builtin_amdgcn_global_load_lds((const unsigned*)(VT + ((size_t)(_key0 >> 6) * 1024 + 256 * h + 128 * hh + R1) * 64 + C1), (LAS unsigned*)(lds + _buf + 32768 + hh * 16384 + 8192 + ldsw), 16, 0, 0); } } while (0)
        RET_ISSUE(0);
        for (int j = 0; j <= qb; ++j) {
            VM_WAIT(); SBAR();
            if (j < qb) RET_ISSUE(j + 1);
            const int buf = (j & 1) * 65536;
            f32x4 s[2]; s[0] = (f32x4){0.f, 0.f, 0.f, 0.f}; s[1] = s[0];
#pragma unroll
            for (int ks = 0; ks < 8; ++ks)
#pragma unroll
                for (int t = 0; t < 2; ++t) { const bf16x8 kf = *(const LAS bf16x8*)(lds + buf + (ks >> 1) * 8192 + lds_byte(32 * wk + 16 * t + fr, (ks & 1) * 32 + fq * 8));
                    s[t] = __builtin_amdgcn_mfma_f32_16x16x32_bf16(kf, qf[ks], s[t], 0, 0, 0); }
            const float cdec = __builtin_amdgcn_exp2f((float)(64 * (qb - j - 1)) * l2g);
            float pv[8];
#pragma unroll
            for (int t = 0; t < 2; ++t)
#pragma unroll
                for (int r = 0; r < 4; ++r) { float v = s[t][r] * cdec; if (j == qb && (32 * wk + 16 * t + 4 * fq + r) > (16 * wq + fr)) v = 0.f; pv[4 * t + r] = v; }
            u32x4 pw; pw.x = cvt_pk_bf16(pv[0], pv[1]); pw.y = cvt_pk_bf16(pv[2], pv[3]); pw.z = cvt_pk_bf16(pv[4], pv[5]); pw.w = cvt_pk_bf16(pv[6], pv[7]);
            const bf16x8 pf = __builtin_bit_cast(bf16x8, pw);
#pragma unroll
            for (int dt = 0; dt < 16; ++dt) { const int d = 16 * dt + fr;
                const u32x2 v0 = *(const LAS u32x2*)(lds + buf + 32768 + (d >> 7) * 16384 + lds_byte(d & 127, 32 * wk + 4 * fq));
                const u32x2 v1 = *(const LAS u32x2*)(lds + buf + 32768 + (d >> 7) * 16384 + lds_byte(d & 127, 32 * wk + 16 + 4 * fq));
                u32x4 vw; vw.x = v0.x; vw.y = v0.y; vw.z = v1.x; vw.w = v1.y;
                o[dt] = __builtin_amdgcn_mfma_f32_16x16x32_bf16(__builtin_bit_cast(bf16x8, vw), pf, o[dt], 0, 0, 0); }
        }
#undef RET_ISSUE
        LDS_WAIT(); SBAR();
        LAS float* X = (LAS float*)lds;
        if (wk == 1) {
#pragma unroll
            for (int dt = 0; dt < 16; ++dt)
#pragma unroll
                for (int r = 0; r < 4; ++r) X[(wq * 64 + dt * 4 + r) * 64 + lane] = o[dt][r];
        }
        LDS_WAIT(); SBAR();
        if (wk == 0) {
            float sm = 0.f;
#pragma unroll
            for (int dt = 0; dt < 16; ++dt)
#pragma unroll
                for (int r = 0; r < 4; ++r) { o[dt][r] += X[(wq * 64 + dt * 4 + r) * 64 + lane]; sm += o[dt][r]; }
            sm += __shfl_xor(sm, 16); sm += __shfl_xor(sm, 32);
            const float mean = sm * (1.f / HD); float s2 = 0.f;
#pragma unroll
            for (int dt = 0; dt < 16; ++dt)
#pragma unroll
                for (int r = 0; r < 4; ++r) { const float dd = o[dt][r] - mean; s2 += dd * dd; }
            s2 += __shfl_xor(s2, 16); s2 += __shfl_xor(s2, 32);
            const float rstd = 1.0f / sqrtf(s2 * (1.f / HD) + LN_EPS);
            const int row = tok0 + 16 * wq + fr;
#pragma unroll
            for (int dt = 0; dt < 16; ++dt) { const int d = 16 * dt + 4 * fq;
                const u32x2 gv = *(const GAS u32x2*)(Gp + (size_t)row * 1024 + 256 * h + d);
                const float y0 = (o[dt][0] - mean) * rstd * bf_lo(gv.x), y1 = (o[dt][1] - mean) * rstd * bf_hi(gv.x), y2 = (o[dt][2] - mean) * rstd * bf_lo(gv.y), y3 = (o[dt][3] - mean) * rstd * bf_hi(gv.y);
                u32x2 w; w.x = cvt_pk_bf16(y0, y1); w.y = cvt_pk_bf16(y2, y3);
                *(GAS u32x2*)(CAT + tiled_idx(NTOK, row, 1024 + 256 * h + d)) = w; }
        }
        LDS_WAIT(); SBAR();
    }
}

struct OutProjOrder {
    int G, c;
    __device__ __forceinline__ bool next(int i, pg8::Unit& u) const {
        const int L = i * G + c; if (L >= 256) return false;
        const int wgid = pg8::xcd_remap(L, 256);
        const int nig = 8 * 8, gid = wgid / nig, fm = gid * 8, pm = fm + ((wgid % nig) % 8), pn = (wgid % nig) / 8;
        u.a = (unsigned)WS_CAT + (unsigned)(256 * pm) * 128u; u.row0 = 256 * pm; u.col0 = 256 * pn; u.kind = 0; u.e = 0;
        u.b0 = (unsigned)WS_WOUT + (unsigned)(256 * pn) * 128u; u.b1 = u.b0 + 128u * 128u;
        return true;
    }
};
struct EpiOutProj {
    unsigned char* wp; const unsigned char* xp;
    __device__ __forceinline__ void operator()(const f32x4 (&acc)[2][2][4][2], const pg8::Unit& u, int wr, int wc, int fr, int fq) const {
        const int cr = wc * 32 + 8 * fq, lrow = wr * 64 + fr;
        f32x4 bv[2][2];
#pragma unroll
        for (int bj = 0; bj < 2; ++bj)
#pragma unroll
            for (int n = 0; n < 2; ++n) bv[bj][n] = gld128f(wp, (unsigned)((u.col0 + cr) * 4 + n * 16), (unsigned)WS_BOUT + bj * 512u);
        const unsigned vo = (unsigned)((u.row0 + lrow) * 8192 + (u.col0 + cr) * 4);
#pragma unroll
        for (int ai = 0; ai < 2; ++ai)
#pragma unroll
            for (int m = 0; m < 4; ++m) {
#pragma unroll
                for (int bj = 0; bj < 2; ++bj)
#pragma unroll
                    for (int n = 0; n < 2; ++n) { const unsigned so = (unsigned)(ai * 128 + m * 16) * 8192u + bj * 512u;
                        const f32x4 xv = gld128f(xp, vo + n * 16, so);
                        gst128(wp, __builtin_bit_cast(u32x4, acc[ai][bj][m][n] + bv[bj][n] + xv * DN_ALPHA), vo + n * 16, (unsigned)WS_PRE1 + so); } }
    }
};

__device__ __forceinline__ void ln1_router_tile(Frame& F, int tile) {
    const float* PRE1 = (const float*)(F.ws + WS_PRE1); float* HF = (float*)(F.ws + WS_HF); unsigned char* HB = F.ws + WS_HB;
    const float* WRT = (const float*)(F.ws + WS_WRT);
    int* ROWTOK = (int*)(F.ws + WS_ROWTOK); int* TOKE = (int*)(F.ws + WS_ASSIGN); int* TOKS = TOKE + NTOK * TOPK; float* TOKG = (float*)(TOKS + NTOK * TOPK);
    LAS float* HT = (LAS float*)F.lds;
    LAS float* RED = (LAS float*)(F.lds + 131328);
    LAS float* LG = (LAS float*)(F.lds + 131328 + 16384);
    const int lane = F.lane, w = F.wave;
#pragma unroll
    for (int tt = 0; tt < 2; ++tt) {
        const int tl = 2 * w + tt, row = tile * 16 + tl;
        const GAS f32x4* pr = (const GAS f32x4*)(PRE1 + (size_t)row * D) + lane;
        f32x4 v[8]; float s = 0.f;
#pragma unroll
        for (int j = 0; j < 8; ++j) { v[j] = pr[64 * j]; s += (v[j].x + v[j].y) + (v[j].z + v[j].w); }
        const float mean = wave_sum(s) * (1.f / D); float s2 = 0.f;
#pragma unroll
        for (int j = 0; j < 8; ++j) { v[j] = v[j] - mean; s2 += (v[j].x * v[j].x + v[j].y * v[j].y) + (v[j].z * v[j].z + v[j].w * v[j].w); }
        const float rstd = 1.0f / sqrtf(wave_sum(s2) * (1.f / D) + LN_EPS);
#pragma unroll
        for (int j = 0; j < 8; ++j) { const int col = 256 * j + 4 * lane;
            const f32x4 g = *(const GAS f32x4*)(F.ln1_g + col), bb = *(const GAS f32x4*)(F.ln1_b + col);
            const f32x4 y = v[j] * rstd * g + bb;
            *(GAS f32x4*)(HF + (size_t)row * D + col) = y;
            int o = __builtin_amdgcn_cvt_pk_fp8_f32(y.x, y.y, 0, false); o = __builtin_amdgcn_cvt_pk_fp8_f32(y.z, y.w, o, true);
            *(GAS int*)(HB + tiled8_idx(NTOK, row, col)) = o;
            *(LAS f32x4*)(HT + tl * 2052 + col) = y; }
    }
    LDS_WAIT(); __syncthreads();
    {
        const int tk = lane & 15, kq = lane >> 4;
        f32x4 a0 = (f32x4){0.f, 0.f, 0.f, 0.f}, a1 = a0;
#pragma unroll 4
        for (int kg = 0; kg < 16; ++kg) { const int k0 = 256 * w + 16 * kg + 4 * kq;
            const f32x4 hv = *(const LAS f32x4*)(HT + tk * 2052 + k0);
            const f32x4 w0 = *(const GAS f32x4*)(WRT + (size_t)tk * D + k0), w1 = *(const GAS f32x4*)(WRT + (size_t)(tk + 16) * D + k0);
#pragma unroll
            for (int i = 0; i < 4; ++i) { a0 = __builtin_amdgcn_mfma_f32_16x16x4f32(hv[i], w0[i], a0, 0, 0, 0); a1 = __builtin_amdgcn_mfma_f32_16x16x4f32(hv[i], w1[i], a1, 0, 0, 0); } }
#pragma unroll
        for (int r = 0; r < 4; ++r) { RED[(w * 16 + 4 * kq + r) * 32 + tk] = a0[r]; RED[(w * 16 + 4 * kq + r) * 32 + 16 + tk] = a1[r]; }
    }
    LDS_WAIT(); __syncthreads();
    { const int t = F.tid >> 5, e = F.tid & 31; float sum = F.b_router[e];
#pragma unroll
        for (int ww = 0; ww < 8; ++ww) sum += RED[(ww * 16 + t) * 32 + e];
        LG[t * 32 + e] = sum; }
    LDS_WAIT(); __syncthreads();
    LAS unsigned* LC = (LAS unsigned*)(F.lds + 131328 + 16384 + 2048);
    if (F.tid < 32) LC[F.tid] = 0u;
    LDS_WAIT(); __syncthreads();
    int ti[4] = {0, 0, 0, 0}; int ls[4] = {0, 0, 0, 0}; float gt[4] = {0.f, 0.f, 0.f, 0.f};
    if (F.tid < 16) {
        float lv[32];
#pragma unroll
        for (int e = 0; e < 32; ++e) lv[e] = LG[F.tid * 32 + e];
        float tv[4];
#pragma unroll
        for (int k = 0; k < 4; ++k) { float best = -3.0e38f; int bi = 0;
#pragma unroll
            for (int e = 0; e < 32; ++e) { const bool taken = (k > 0 && ti[0] == e) || (k > 1 && ti[1] == e) || (k > 2 && ti[2] == e); if (!taken && lv[e] > best) { best = lv[e]; bi = e; } }
            tv[k] = best; ti[k] = bi; }
        const float e1 = __expf(tv[1] - tv[0]), e2 = __expf(tv[2] - tv[0]), e3 = __expf(tv[3] - tv[0]);
        const float inv = 1.0f / (1.0f + e1 + e2 + e3);
        gt[0] = inv; gt[1] = e1 * inv; gt[2] = e2 * inv; gt[3] = e3 * inv;
#pragma unroll
        for (int k = 0; k < 4; ++k) ls[k] = (int)__hip_atomic_fetch_add(LC + ti[k], 1u, __ATOMIC_RELAXED, __HIP_MEMORY_SCOPE_WORKGROUP);
    }
    LDS_WAIT(); __syncthreads();
    if (F.tid < 32) { const unsigned c = LC[F.tid]; unsigned base = 0u; if (c) base = atomicAdd(F.ctl + CW_CNT + 64 * F.tid, c); LC[32 + F.tid] = base; }
    LDS_WAIT(); __syncthreads();
    if (F.tid < 16) {
        const int tok = tile * 16 + F.tid;
#pragma unroll
        for (int k = 0; k < 4; ++k) { const int slot = (int)LC[32 + ti[k]] + ls[k];
            ROWTOK[ti[k] * NTOK + slot] = tok; TOKE[tok * 4 + k] = ti[k]; TOKS[tok * 4 + k] = slot; TOKG[tok * 4 + k] = gt[k]; }
    }
    __syncthreads();
}

__device__ __forceinline__ void build_tile_table(Frame& F) {
    LAS int* TS = (LAS int*)(F.lds + TS_OFF);
    if (F.tid == 0) { int acc = 0;
        for (int e = 0; e < NE; ++e) { const int c = (int)__hip_atomic_load(F.ctl + CW_CNT + 64 * e, __ATOMIC_RELAXED, __HIP_MEMORY_SCOPE_AGENT); TS[e] = acc; TS[40 + e] = c; acc += (c + 255) >> 8; }
        TS[NE] = acc; }
    LDS_WAIT(); __syncthreads();
}
struct MoeOrder {
    LAS const int* TS; const int* ROWTOK; int G, c, NT, total; unsigned wstride; int wrow_gate_up;
    __device__ __forceinline__ bool next(int i, pg8::Unit& u) const {
        const int L = i * G + c; if (L >= total) return false;
        const int wg = pg8::xcd_remap(L, total);
        const int mtg = wg / NT, nt = wg - mtg * NT;
        int e = 0;
#pragma unroll 1
        for (int k = 1; k < NE; ++k) if (TS[k] <= mtg) e = k;
        u.e = e; u.kind = mtg - TS[e]; u.row0 = 256 * mtg;
        const unsigned wb = (wrow_gate_up ? (unsigned)WS_WGU : (unsigned)WS_WD) + (unsigned)e * wstride;
        if (wrow_gate_up) { u.col0 = 128 * nt; u.b0 = wb + (unsigned)(128 * nt) * 128u; u.b1 = wb + (unsigned)(FF + 128 * nt) * 128u; }
        else { u.col0 = 256 * nt; u.b0 = wb + (unsigned)(256 * nt) * 128u; u.b1 = u.b0 + 128u * 128u; }
        u.a = wrow_gate_up ? (unsigned)WS_HB : (unsigned)WS_HH + (unsigned)(256 * mtg) * 128u;
        return true;
    }
    __device__ __forceinline__ void prep(LAS unsigned char* tab, int tid) const {
        LAS int* T = (LAS int*)tab;
        for (int i = 0; i < 12; ++i) { pg8::Unit u; if (!next(i, u)) break;
            if (tid < 256) { const int cnt = TS[40 + u.e], s = 256 * u.kind + tid; T[i * 256 + tid] = s < cnt ? ROWTOK[u.e * NTOK + s] : 0; } }
        asm volatile("s_waitcnt vmcnt(0) lgkmcnt(0)" ::: "memory"); __syncthreads();
    }
    __device__ __forceinline__ void gather(LAS const unsigned char* tab, int i, int R0, int C0, int R1, int C1, unsigned& o00, unsigned& o01, unsigned& o10, unsigned& o11) const {
        LAS const int* T = (LAS const int*)tab + i * 256;
        o00 = (unsigned)(T[R0] * 128 + C0 * 2); o01 = (unsigned)(T[R1] * 128 + C1 * 2); o10 = (unsigned)(T[128 + R0] * 128 + C0 * 2); o11 = (unsigned)(T[128 + R1] * 128 + C1 * 2);
    }
};
struct EpiSwiglu {
    rsrc_t rs; const float* bp; unsigned char* wp;
    __device__ __forceinline__ void operator()(const f32x4 (&acc)[2][2][4][2], const pg8::Unit& u, int wr, int wc, int fr, int fq) const {
        const int cr = wc * 32 + 8 * fq, lrow = wr * 64 + fr;
        f32x4 bv[2][2];
#pragma unroll
        for (int bj = 0; bj < 2; ++bj)
#pragma unroll
            for (int n = 0; n < 2; ++n) bv[bj][n] = gld128f(wp, (unsigned)((u.e * 2 * FF + u.col0 + cr) * 4 + n * 16), (unsigned)WS_BGU + bj * (unsigned)(FF * 4));
        const unsigned vo = (unsigned)((((u.col0 >> 7) * HROWS + u.row0) + lrow) * 128 + cr);
#pragma unroll
        for (int ai = 0; ai < 2; ++ai)
#pragma unroll
            for (int m = 0; m < 4; ++m) {
                float o[8];
#pragma unroll
                for (int n = 0; n < 2; ++n)
#pragma unroll
                    for (int j = 0; j < 4; ++j) { const float xg = fminf(acc[ai][0][m][n][j] * (1.0f / WGU_SCALE) + bv[0][n][j], 7.0f); const float xl = fminf(fmaxf(acc[ai][1][m][n][j] * (1.0f / WGU_SCALE) + bv[1][n][j], -7.0f), 7.0f);
                        o[4 * n + j] = xg * __builtin_amdgcn_rcpf(1.0f + __builtin_amdgcn_exp2f(-1.702f * 1.4426950408889634f * xg)) * (xl + 1.0f); }
                u32x2 w; int p0 = __builtin_amdgcn_cvt_pk_fp8_f32(o[0], o[1], 0, false); p0 = __builtin_amdgcn_cvt_pk_fp8_f32(o[2], o[3], p0, true);
                int p1 = __builtin_amdgcn_cvt_pk_fp8_f32(o[4], o[5], 0, false); p1 = __builtin_amdgcn_cvt_pk_fp8_f32(o[6], o[7], p1, true); w.x = (unsigned)p0; w.y = (unsigned)p1;
                gst64(wp, w, vo, (unsigned)WS_HH + (unsigned)(ai * 128 + m * 16) * 128u); }
    }
};
struct EpiDown {
    rsrc_t rs; const float* bp; unsigned char* wp;
    __device__ __forceinline__ void operator()(const f32x4 (&acc)[2][2][4][2], const pg8::Unit& u, int wr, int wc, int fr, int fq) const {
        const int cr = wc * 32 + 8 * fq, lrow = wr * 64 + fr;
        f32x4 bv[2][2];
#pragma unroll
        for (int bj = 0; bj < 2; ++bj)
#pragma unroll
            for (int n = 0; n < 2; ++n) bv[bj][n] = gld128f(wp, (unsigned)((u.e * D + u.col0 + cr) * 4 + n * 16), (unsigned)WS_BDN + bj * 512u);
        const unsigned vo = (unsigned)((u.row0 + lrow) * 4096 + (u.col0 + cr) * 2);
#pragma unroll
        for (int ai = 0; ai < 2; ++ai)
#pragma unroll
            for (int m = 0; m < 4; ++m) {
#pragma unroll
                for (int bj = 0; bj < 2; ++bj) { const f32x4 v0 = acc[ai][bj][m][0] * (1.0f / WD_SCALE) + bv[bj][0], v1 = acc[ai][bj][m][1] * (1.0f / WD_SCALE) + bv[bj][1];
                    u32x4 w; w.x = cvt_pk_bf16(v0[0], v0[1]); w.y = cvt_pk_bf16(v0[2], v0[3]); w.z = cvt_pk_bf16(v1[0], v1[1]); w.w = cvt_pk_bf16(v1[2], v1[3]);
                    gst128(wp, w, vo, (unsigned)WS_Y + (unsigned)(ai * 128 + m * 16) * 4096u + bj * 256u); } }
    }
};

__device__ __forceinline__ void combine_row(Frame& F, int row) {
    const float* HF = (const float*)(F.ws + WS_HF); const bf16_t* Y = (const bf16_t*)(F.ws + WS_Y);
    const int* TOKE = (const int*)(F.ws + WS_ASSIGN); const int* TOKS = TOKE + NTOK * TOPK; const float* TOKG = (const float*)(TOKS + NTOK * TOPK);
    LAS const int* TS = (LAS const int*)(F.lds + TS_OFF);
    const int lane = F.lane;
    f32x4 v[8];
    const GAS f32x4* hr = (const GAS f32x4*)(HF + (size_t)row * D) + lane;
#pragma unroll
    for (int j = 0; j < 8; ++j) v[j] = hr[64 * j] * DN_ALPHA;
#pragma unroll
    for (int k = 0; k < 4; ++k) { const int e = TOKE[row * 4 + k], slot = TOKS[row * 4 + k]; const float g = TOKG[row * 4 + k];
        const bf16_t* yr = Y + (size_t)(256 * TS[e] + slot) * D + 4 * lane;
#pragma unroll
        for (int j = 0; j < 8; ++j) { const u32x2 yv = *(const GAS u32x2*)(yr + 256 * j);
            v[j].x += g * bf_lo(yv.x); v[j].y += g * bf_hi(yv.x); v[j].z += g * bf_lo(yv.y); v[j].w += g * bf_hi(yv.y); } }
    float s = 0.f;
#pragma unroll
    for (int j = 0; j < 8; ++j) s += (v[j].x + v[j].y) + (v[j].z + v[j].w);
    const float mean = wave_sum(s) * (1.f / D); float s2 = 0.f;
#pragma unroll
    for (int j = 0; j < 8; ++j) { v[j] = v[j] - mean; s2 += (v[j].x * v[j].x + v[j].y * v[j].y) + (v[j].z * v[j].z + v[j].w * v[j].w); }
    const float rstd = 1.0f / sqrtf(wave_sum(s2) * (1.f / D) + LN_EPS);
#pragma unroll
    for (int j = 0; j < 8; ++j) { const int col = 256 * j + 4 * lane;
        const f32x4 g = *(const GAS f32x4*)(F.ln2_g + col), bb = *(const GAS f32x4*)(F.ln2_b + col);
        *(GAS f32x4*)(F.out + (size_t)row * D + col) = v[j] * rstd * g + bb; }
}

struct Args { const float* in[19]; float* out; unsigned char* ws; int ph_lo, ph_hi; };
__global__ void __launch_bounds__(512, 2) fwd_kernel(Args args) {
    extern __shared__ __attribute__((aligned(16))) unsigned char lds_raw[];
    Frame F;
    F.lds = (LAS unsigned char*)lds_raw;
    F.wave = __builtin_amdgcn_readfirstlane((int)threadIdx.x >> 6); F.lane = lane_id_opaque(); F.tid = F.wave * 64 + F.lane;
#define RETID() do { F.lane = lane_id_opaque(); F.tid = F.wave * 64 + F.lane; } while (0)
    F.G = gridDim.x; { const int bx = blockIdx.x; F.vcu = (F.G % 8 == 0) ? (bx % 8) * (F.G / 8) + bx / 8 : bx; }
    F.ws = args.ws; F.ctl = (unsigned*)(args.ws + WS_CTL); F.out = args.out;
    F.x = args.in[0]; F.w_in = args.in[1]; F.b_in = args.in[2]; F.conv_w = args.in[3]; F.conv_b = args.in[4]; F.conv_ln_g = args.in[5]; F.conv_ln_b = args.in[6];
    F.w_out = args.in[7]; F.b_out = args.in[8]; F.ln1_g = args.in[9]; F.ln1_b = args.in[10]; F.w_router = args.in[11]; F.b_router = args.in[12];
    F.w_gu = args.in[13]; F.b_gu = args.in[14]; F.w_down = args.in[15]; F.b_down = args.in[16]; F.ln2_g = args.in[17]; F.ln2_b = args.in[18];
    for (int u = (int)threadIdx.x; u < (LDS_BYTES - LDSCTL_OFF) / 4; u += 512) ((LAS unsigned*)(F.lds + LDSCTL_OFF))[u] = 0u;
    __syncthreads();
    XcdBarrier bar; bar.bar = F.ctl + CW_BAR; bar.x = 0; bar.st = nullptr;
    if (N_LAUNCHES == 1) bar = xcd_barrier_post(F.ctl + CW_BAR, (volatile LAS unsigned*)(F.lds + LDSCTL_OFF));
    const int lo = args.ph_lo, hi = args.ph_hi;
#define IN(k) (lo <= (k) && (k) < hi)
#define SEAM(k) do { if (IN(k) && IN((k) + 1)) xcd_barrier(bar, F.wave); } while (0)
#define REPS(k) for (int rep_ = 0; rep_ < (((k) == PROBE_DUP && N_LAUNCHES == 1) ? 2 : 1); ++rep_)
#define REPBAR() do { if (rep_ == 0 && PROBE_DUP >= 0 && N_LAUNCHES == 1) xcd_barrier(bar, F.wave); } while (0)
    const __amdgpu_buffer_rsrc_t rs = __builtin_amdgcn_make_buffer_rsrc((void*)F.ws, 0, (int)WS_END, 0x00020000);

    if (IN(0)) { p0_prologue(F); SEAM(0); }

    const int NR = moe_rounds(F.G), r1 = (NR * 10) / 24, r2 = (NR * 16) / 24, r3 = (NR * 20) / 24;

    if (IN(1)) {
        EpiInProj E{F.ws};
        const int g4 = F.vcu & 3;
        if (g4 == 0) { RETID(); moe_convert(F, 0, r1); }
        { InProjOrder S{F.G, (int)blockIdx.x, 0}; pg8::gemm_phase<EpiInProj, InProjOrder, false, false>(F.lds, F.wave, S, E, rs, (unsigned)NTOK * 128u, (unsigned)NPROJ * 128u); }
        if (g4 == 1) { RETID(); moe_convert(F, 0, r1); }
        { InProjOrder S{F.G, (int)blockIdx.x, 1}; pg8::gemm_phase<EpiInProj, InProjOrder, false, false>(F.lds, F.wave, S, E, rs, (unsigned)NTOK * 128u, (unsigned)NPROJ * 128u); }
        if (g4 == 2) { RETID(); moe_convert(F, 0, r1); }
        { InProjOrder S{F.G, (int)blockIdx.x, 2}; pg8::gemm_phase<EpiInProj, InProjOrder, false, false>(F.lds, F.wave, S, E, rs, (unsigned)NTOK * 128u, (unsigned)NPROJ * 128u); }
        { InProjVtOrder S{(int)blockIdx.x}; pg8::gemm_phase<EpiInProj, InProjVtOrder, false, false>(F.lds, F.wave, S, E, rs, (unsigned)NPROJ * 128u, (unsigned)NTOK * 128u); }
        if (g4 == 3) { RETID(); moe_convert(F, 0, r1); }
        SEAM(1);
    }

    if (IN(2)) {
        const int g3 = F.vcu % 3;
        RETID(); if (g3 == 0) moe_convert(F, r1, r2);
        for (int u = F.vcu; u < 256; u += F.G) ret_unit(F, u);
        __syncthreads();
        RETID(); if (g3 == 1) moe_convert(F, r1, r2);
        for (int u = F.vcu; u < 256; u += F.G) conv_unit(F, u);
        RETID(); if (g3 == 2) moe_convert(F, r1, r2);
        SEAM(2);
    }

    if (IN(3)) {
        const int g2 = F.vcu & 1;
        if (g2 == 0) { RETID(); moe_convert(F, r2, r3); }
        { OutProjOrder S{F.G, (int)blockIdx.x};
        EpiOutProj E{F.ws, (const unsigned char*)F.x};
        pg8::gemm_phase<EpiOutProj, OutProjOrder, false, false>(F.lds, F.wave, S, E, rs, (unsigned)NTOK * 128u, (unsigned)D * 128u); }
        if (g2 == 1) { RETID(); moe_convert(F, r2, r3); }
        SEAM(3);
    }

    if (IN(4)) {
        const int g3 = F.vcu % 3; int t = F.vcu;
        if (g3 == 0) { RETID(); moe_convert(F, r3, NR); }
        RETID(); if (t < NTOK / 16) { ln1_router_tile(F, t); t += F.G; }
        if (g3 == 1) { RETID(); moe_convert(F, r3, NR); }
        RETID(); for (; t < NTOK / 16; t += F.G) ln1_router_tile(F, t);
        if (g3 == 2) { RETID(); moe_convert(F, r3, NR); }
        SEAM(4);
    }

    if (IN(5) || IN(6) || IN(7)) { RETID(); build_tile_table(F); }

    if (IN(5)) { REPS(5) {
        LAS const int* TS = (LAS const int*)(F.lds + TS_OFF);
        MoeOrder S{TS, (const int*)(F.ws + WS_ROWTOK), F.G, (int)blockIdx.x, 16, TS[NE] * 16, (unsigned)(D * 2 * FF), 1};
        EpiSwiglu E{rs, F.b_gu, F.ws};
        pg8::gemm_phase<EpiSwiglu, MoeOrder, true, true>(F.lds, F.wave, S, E, rs, (unsigned)NTOK * 128u, (unsigned)(2 * FF) * 128u);
        if (PROBE_DUP == 5) REPBAR(); }
        SEAM(5);
    }

    if (IN(6)) { REPS(6) {
        LAS const int* TS = (LAS const int*)(F.lds + TS_OFF);
        MoeOrder S{TS, (const int*)(F.ws + WS_ROWTOK), F.G, (int)blockIdx.x, 8, TS[NE] * 8, (unsigned)(FF * D), 0};
        EpiDown E{rs, F.b_down, F.ws};
        pg8::gemm_phase<EpiDown, MoeOrder, false, true>(F.lds, F.wave, S, E, rs, (unsigned)HROWS * 128u, (unsigned)D * 128u);
        if (PROBE_DUP == 6) REPBAR(); }
        SEAM(6);
    }

    if (IN(7)) { RETID(); REPS(7) {
        for (int m = F.vcu * 8 + F.wave; m < NTOK; m += F.G * 8) combine_row(F, m);
        if (PROBE_DUP == 7) REPBAR(); }
    }
#undef IN
#undef SEAM
}

extern "C" void kernel_launch(void* const* d_in, const int* in_sizes, int n_in, void* d_out, int out_size, void* d_ws, size_t ws_size, hipStream_t stream) {
    static int grid = 0;
    if (grid == 0) {
        if (n_in != 19 || out_size != NTOK * D || ws_size < WS_END) { fprintf(stderr, "kernel_launch: unexpected problem (n_in %d, out %d, ws %zu)\n", n_in, out_size, ws_size); grid = -1; return; }
        int dev = 0, cus = 0, per_cu = 0;
        if (hipGetDevice(&dev) != hipSuccess || hipDeviceGetAttribute(&cus, hipDeviceAttributeMultiprocessorCount, dev) != hipSuccess) { grid = -1; return; }
        if (hipFuncSetAttribute((const void*)fwd_kernel, hipFuncAttributeMaxDynamicSharedMemorySize, LDS_BYTES) != hipSuccess) { fprintf(stderr, "kernel_launch: hipFuncSetAttribute failed\n"); grid = -1; return; }
        if (hipOccupancyMaxActiveBlocksPerMultiprocessor(&per_cu, (const void*)fwd_kernel, 512, LDS_BYTES) != hipSuccess || per_cu < 1) fprintf(stderr, "kernel_launch: occupancy query says %d\n", per_cu);
        (void)hipGetLastError();
        grid = cus;
    }
    if (grid < 0) return;
    if (hipMemsetAsync((char*)d_ws + WS_CTL, 0, CTL_ZERO_BYTES, stream) != hipSuccess) return;
    Args a{};
    for (int i = 0; i < 19; ++i) a.in[i] = (const float*)d_in[i];
    a.out = (float*)d_out; a.ws = (unsigned char*)d_ws;
    if (N_LAUNCHES == 1) { a.ph_lo = 0; a.ph_hi = NPHASES; hipLaunchKernelGGL(fwd_kernel, dim3(grid), dim3(512), LDS_BYTES, stream, a); }
    else for (int p = 0; p < NPHASES; ++p) { a.ph_lo = p; a.ph_hi = p + 1; for (int r = 0; r < (p == PROBE_DUP ? 2 : 1); ++r) hipLaunchKernelGGL(fwd_kernel, dim3(grid), dim3(512), LDS_BYTES, stream, a); }
}
```

```cpp
#include <hip/hip_runtime.h>
#include <cstdio>
#include <cstdint>

#ifndef MK_N_LAUNCHES
#define MK_N_LAUNCHES 1
#endif
#ifndef PROBE_DUP
#define PROBE_DUP -1
#endif
#ifndef PROBE_TS_A
#define PROBE_TS_A -1
#endif

#define GAS __attribute__((address_space(1)))
#define LAS __attribute__((address_space(3)))
typedef unsigned short bf16_t;
typedef short bf16x8 __attribute__((ext_vector_type(8)));
typedef short bf16x4 __attribute__((ext_vector_type(4)));
typedef float f32x4 __attribute__((ext_vector_type(4)));
typedef float f32x2 __attribute__((ext_vector_type(2)));
typedef unsigned u32x4 __attribute__((ext_vector_type(4)));
typedef unsigned u32x2 __attribute__((ext_vector_type(2)));
typedef int v4i_t __attribute__((ext_vector_type(4)));
typedef int v8i_t __attribute__((ext_vector_type(8)));
typedef short v2s_t __attribute__((ext_vector_type(2)));

constexpr int D = 2048, NTOK = 8192, SEQ = 2048, CW = 1024, NH = 4, HD = 256, NPROJ = 6144, NE = 32, TOPK = 4, FF = 2048, CK = 31;
constexpr int HROWS = 40960;
constexpr float LN_EPS = 1e-5f;
constexpr float DN_ALPHA = 1.189207115002721f;
constexpr int NPHASES = 8;
#ifndef MOE_LD_AUX
#define MOE_LD_AUX 2
#endif
constexpr float WGU_SCALE = 32.0f, WD_SCALE = 64.0f; constexpr float Y_SCALE = 8.0f;
constexpr int N_LAUNCHES = MK_N_LAUNCHES;

constexpr size_t MiB = 1u << 20;
constexpr size_t WS_CTL = 0, CTL_ZERO_BYTES = 1 * MiB;
constexpr size_t WS_ROWTOK = 1 * MiB;
constexpr size_t WS_ASSIGN = 2 * MiB;
constexpr size_t WS_ROPE = 3 * MiB;
constexpr size_t WS_WRT = 5 * MiB;
constexpr size_t WS_BIN = 6 * MiB, WS_BOUT = WS_BIN + 32768, WS_BGU = WS_BIN + 65536, WS_BDN = WS_BGU + 524288;
constexpr size_t WS_XT = 8 * MiB;
constexpr size_t WS_WIN = 40 * MiB;
constexpr size_t WS_WOUT = 64 * MiB;
constexpr size_t WS_UG = 72 * MiB;
constexpr size_t WS_Q = 88 * MiB;
constexpr size_t WS_K = 104 * MiB;
constexpr size_t WS_VT = 120 * MiB;
constexpr size_t WS_G = 136 * MiB;
constexpr size_t WS_CAT = 152 * MiB;
constexpr size_t WS_PRE1 = 184 * MiB;
constexpr size_t WS_HF = 248 * MiB;
constexpr size_t WS_HB = 312 * MiB;
constexpr size_t WS_HH = 344 * MiB;
constexpr size_t WS_Y = 504 * MiB;
constexpr size_t WS_WGU = 672 * MiB;
constexpr size_t WS_WD = 1184 * MiB;
constexpr size_t WS_END = 1440 * MiB;
constexpr int CW_CNT = 64;
constexpr int CW_BAR = 4096;

constexpr int LDS_BYTES = 163840;
constexpr int LDSCTL_OFF = 159744;
constexpr int TS_OFF = LDSCTL_OFF + 256;
constexpr int AUX_OFF = 131072, AUX_TOK = AUX_OFF, AUX_BIAS = AUX_OFF + 12288, AUX_UT = AUX_OFF + 13312;

#define LDS_WAIT() asm volatile("s_waitcnt lgkmcnt(0)" ::: "memory")
#define VM_WAIT() asm volatile("s_waitcnt vmcnt(0)" ::: "memory")
#define SBAR() __builtin_amdgcn_s_barrier()

__device__ __forceinline__ unsigned cvt_pk_bf16(float lo, float hi) { unsigned r; asm volatile("v_cvt_pk_bf16_f32 %0, %1, %2" : "=v"(r) : "v"(lo), "v"(hi)); return r; }
__device__ __forceinline__ float bf_lo(unsigned u) { return __builtin_bit_cast(float, u << 16); }
__device__ __forceinline__ float bf_hi(unsigned u) { return __builtin_bit_cast(float, u & 0xffff0000u); }
__device__ __forceinline__ float wave_sum(float v) {
#pragma unroll
    for (int o = 1; o < 64; o <<= 1) v += __shfl_xor(v, o);
    return v;
}
__device__ __forceinline__ int lane_id_opaque() { int l; asm volatile("v_mbcnt_lo_u32_b32 %0, -1, 0\n\tv_mbcnt_hi_u32_b32 %0, -1, %0" : "=v"(l)); return l; }
__device__ __forceinline__ float sigmoidf_(float x) { return __builtin_amdgcn_rcpf(1.0f + __builtin_amdgcn_exp2f(-1.4426950408889634f * x)); }

typedef __amdgpu_buffer_rsrc_t rsrc_t;
__device__ __forceinline__ u32x4 bld128(rsrc_t r, unsigned voff, unsigned soff) { return __builtin_amdgcn_raw_buffer_load_b128(r, (int)voff, (int)soff, 0); }
__device__ __forceinline__ f32x4 bld128f(rsrc_t r, unsigned voff, unsigned soff) { return __builtin_bit_cast(f32x4, __builtin_amdgcn_raw_buffer_load_b128(r, (int)voff, (int)soff, 0)); }
__device__ __forceinline__ float bld32f(rsrc_t r, unsigned voff, unsigned soff) { return __builtin_bit_cast(float, __builtin_amdgcn_raw_buffer_load_b32(r, (int)voff, (int)soff, 0)); }
__device__ __forceinline__ void bst128(rsrc_t r, u32x4 v, unsigned voff, unsigned soff) { __builtin_amdgcn_raw_buffer_store_b128(v, r, (int)voff, (int)soff, 0); }
__device__ __forceinline__ f32x4 gld128f(const unsigned char* wp, unsigned voff, unsigned soff) { return *(const GAS f32x4*)((const GAS unsigned char*)(wp + soff) + voff); }
__device__ __forceinline__ float gld32f(const unsigned char* wp, unsigned voff, unsigned soff) { return *(const GAS float*)((const GAS unsigned char*)(wp + soff) + voff); }
__device__ __forceinline__ void gst128(unsigned char* wp, u32x4 v, unsigned voff, unsigned soff) { *(GAS u32x4*)((GAS unsigned char*)(wp + soff) + voff) = v; }
__device__ __forceinline__ void gst64(unsigned char* wp, u32x2 v, unsigned voff, unsigned soff) { *(GAS u32x2*)((GAS unsigned char*)(wp + soff) + voff) = v; }
__device__ __forceinline__ void bst64(rsrc_t r, u32x2 v, unsigned voff, unsigned soff) { __builtin_amdgcn_raw_buffer_store_b64(v, r, (int)voff, (int)soff, 0); }

namespace pg8 {
constexpr int BM = 256, BK = 64, HALF = 128, HTB = HALF * BK * 2, STAGE_BYTES = 8 * HTB;
__host__ __device__ __forceinline__ int lds_byte(int r, int c) { const int st = (r >> 4) * 2 + (c >> 5), rr = r & 15, cc = c & 31, ob = rr * 64 + cc * 2; return st * 1024 + (ob ^ (((ob >> 9) & 1) << 5)); }
__host__ __device__ __forceinline__ void stage_rc(int b, int& R, int& C) { const int st = b / 1024, sb = b % 1024, swz = sb ^ (((sb >> 9) & 1) << 5); R = (st >> 1) * 16 + swz / 64; C = (st & 1) * 32 + (swz % 64) / 2; }
__host__ __device__ __forceinline__ int perm32(int rho) { const int n = rho >> 4, i = rho & 15; return 8 * (i >> 2) + 4 * n + (i & 3); }
__host__ __device__ __forceinline__ int xcd_remap(int L, int nwg) { const int q = nwg / 8, r = nwg % 8, xcd = L % 8, off = L / 8; return (xcd < r ? xcd * (q + 1) : r * (q + 1) + (xcd - r) * q) + off; }

struct Unit { unsigned a, b0, b1; int kind, row0, col0, e; };

template <class Epi, class Sched, bool GATHER, bool FP8>
__device__ __forceinline__ void gemm_phase(LAS unsigned char* lds, const int wid, const Sched& S, const Epi& E, const __amdgpu_buffer_rsrc_t rs, const unsigned kstepA, const unsigned kstepB) {
    const int lane = lane_id_opaque(), tid = wid * 64 + lane, wr = wid >> 2, wc = wid & 3, fr = lane & 15, fq = lane >> 4;
    constexpr int nt = FP8 ? 16 : 32;
    int R0, C0, R1, C1; stage_rc(tid * 16, R0, C0); stage_rc(tid * 16 + 8192, R1, C1);
    const unsigned vB0 = (unsigned)(((R0 & ~31) + perm32(R0 & 31)) * 128 + C0 * 2), vB1 = (unsigned)(((R1 & ~31) + perm32(R1 & 31)) * 128 + C1 * 2);
    unsigned cA00, cA01, cA10, cA11;
    const unsigned ldsw = (unsigned)wid * 1024u;
    const int aoff = lds_byte(wr * 64 + fr, fq * 8), boff = lds_byte(wc * 32 + fr, fq * 8);
#define PG8_SA(b, h) (((b) * 2 + (h)) * HTB)
#define PG8_SB(b, h) ((4 + (b) * 2 + (h)) * HTB)
#define PG8_LD1(rs, bufoff, vo, so, i) __builtin_amdgcn_raw_ptr_buffer_load_lds(rs, (LAS unsigned*)(lds + (bufoff) + ldsw + (i) * 8192), 16, (int)(vo), (int)(so), 0, 0)
#define PG8_STAGE_B(bufoff, so) do { PG8_LD1(rs, bufoff, vB0, so, 0); PG8_LD1(rs, bufoff, vB1, so, 1); } while (0)
#define PG8_STAGE_A(bufoff, so, o0, o1) do { PG8_LD1(rs, bufoff, o0, so, 0); PG8_LD1(rs, bufoff, o1, so, 1); } while (0)
#define PG8_LDA(dst, b, h) do { _Pragma("unroll") for (int m = 0; m < 4; ++m) { const v4i_t _l = *(const LAS v4i_t*)(lds + PG8_SA(b, h) + aoff + m * 2048), _h = *(const LAS v4i_t*)(lds + PG8_SA(b, h) + aoff + m * 2048 + 1024); \
        dst[m] = __builtin_shufflevector(_l, _h, 0, 1, 2, 3, 4, 5, 6, 7); } } while (0)
#define PG8_LDB(dst, b, h) do { _Pragma("unroll") for (int n = 0; n < 2; ++n) { const v4i_t _l = *(const LAS v4i_t*)(lds + PG8_SB(b, h) + boff + n * 2048), _h = *(const LAS v4i_t*)(lds + PG8_SB(b, h) + boff + n * 2048 + 1024); \
        dst[n] = __builtin_shufflevector(_l, _h, 0, 1, 2, 3, 4, 5, 6, 7); } } while (0)
#define PG8_MMA(ai, bj, At, Bt) do { __builtin_amdgcn_s_setprio(1); _Pragma("unroll") for (int m = 0; m < 4; ++m) _Pragma("unroll") for (int n = 0; n < 2; ++n) { \
        if constexpr (FP8) { acc[ai][bj][m][n] = __builtin_amdgcn_mfma_scale_f32_16x16x128_f8f6f4(Bt[n], At[m], acc[ai][bj][m][n], 0, 0, 0, 0, 0, 0); }     \
        else { acc[ai][bj][m][n] = __builtin_amdgcn_mfma_f32_16x16x32_bf16(__builtin_bit_cast(bf16x8, __builtin_shufflevector(Bt[n], Bt[n], 0, 1, 2, 3)), __builtin_bit_cast(bf16x8, __builtin_shufflevector(At[m], At[m], 0, 1, 2, 3)), acc[ai][bj][m][n], 0, 0, 0); \
               acc[ai][bj][m][n] = __builtin_amdgcn_mfma_f32_16x16x32_bf16(__builtin_bit_cast(bf16x8, __builtin_shufflevector(Bt[n], Bt[n], 4, 5, 6, 7)), __builtin_bit_cast(bf16x8, __builtin_shufflevector(At[m], At[m], 4, 5, 6, 7)), acc[ai][bj][m][n], 0, 0, 0); } } \
        __builtin_amdgcn_s_setprio(0); } while (0)
#define PG8_WAIT_V(n) asm volatile("s_waitcnt vmcnt(" #n ")" ::: "memory")
#define PG8_WAIT_L(n) asm volatile("s_waitcnt lgkmcnt(" #n ")" ::: "memory")
#define PG8_BAR __builtin_amdgcn_s_barrier()
#define PG8_SCHED __builtin_amdgcn_sched_barrier(0)
    Unit cur, nxt; int ui = 0;
    S.prep(lds, tid);
    if (!S.next(0, cur)) return;
    if constexpr (GATHER) { S.gather(lds + AUX_TOK, 0, R0, C0, R1, C1, cA00, cA01, cA10, cA11); }
    else { cA00 = (unsigned)(R0 * 128 + C0 * 2); cA01 = (unsigned)(R1 * 128 + C1 * 2); cA10 = cA00 + 16384u; cA11 = cA01 + 16384u; }
    f32x4 acc[2][2][4][2];
#pragma unroll
    for (int a = 0; a < 2; ++a)
#pragma unroll
        for (int b = 0; b < 2; ++b)
#pragma unroll
            for (int m = 0; m < 4; ++m)
#pragma unroll
                for (int n = 0; n < 2; ++n) acc[a][b][m][n] = (f32x4){0.f, 0.f, 0.f, 0.f};
    v8i_t At[4], B0[2], B1[2];
    unsigned cA = cur.a, cB0 = cur.b0, cB1 = cur.b1;
    PG8_STAGE_B(PG8_SB(0, 0), cB0); PG8_STAGE_B(PG8_SB(0, 1), cB1); PG8_STAGE_A(PG8_SA(0, 0), cA, cA00, cA01); PG8_STAGE_A(PG8_SA(0, 1), cA, cA10, cA11);
    if (wr == 1) PG8_BAR;
    PG8_WAIT_V(2); PG8_BAR;
    PG8_STAGE_B(PG8_SB(1, 0), cB0 + kstepB); PG8_STAGE_A(PG8_SA(1, 0), cA + kstepA, cA00, cA01); PG8_STAGE_B(PG8_SB(1, 1), cB1 + kstepB);
    PG8_WAIT_V(6); PG8_BAR;
    for (;;) {
        const bool has_next = S.next(ui + 1, nxt);
        const unsigned nA = has_next ? nxt.a : cA, nB0 = has_next ? nxt.b0 : cB0, nB1 = has_next ? nxt.b1 : cB1;
        for (int t = 0; t < nt; t += 2) {
            const bool last = (t == nt - 2);
            const unsigned a1 = cA + (unsigned)(t + 1) * kstepA;
            const unsigned a2 = last ? nA : cA + (unsigned)(t + 2) * kstepA;
            const unsigned b02 = last ? nB0 : cB0 + (unsigned)(t + 2) * kstepB, b12 = last ? nB1 : cB1 + (unsigned)(t + 2) * kstepB;
            const unsigned a3 = a2 + kstepA, b03 = b02 + kstepB, b13 = b12 + kstepB;
            if (last) E.prefetch(cur, wid, lane_id_opaque(), lds, rs);
            PG8_LDB(B0, 0, 0); PG8_LDB(B1, 0, 1); PG8_SCHED; PG8_LDA(At, 0, 0); PG8_STAGE_A(PG8_SA(1, 1), a1, cA10, cA11);
            PG8_WAIT_V(8); PG8_WAIT_L(0); PG8_BAR; PG8_MMA(0, 0, At, B0); PG8_MMA(0, 1, At, B1); PG8_BAR; PG8_SCHED;
            if constexpr (GATHER) { if (last && has_next) S.gather(lds + AUX_TOK, ui + 1, R0, C0, R1, C1, cA00, cA01, cA10, cA11); }
            PG8_LDA(At, 0, 1); PG8_STAGE_B(PG8_SB(0, 0), b02); PG8_STAGE_B(PG8_SB(0, 1), b12); PG8_STAGE_A(PG8_SA(0, 0), a2, cA00, cA01);
            PG8_WAIT_V(8); PG8_WAIT_L(0); PG8_BAR; PG8_MMA(1, 0, At, B0); PG8_MMA(1, 1, At, B1); PG8_BAR; PG8_SCHED;
            PG8_LDB(B0, 1, 0); PG8_LDB(B1, 1, 1); PG8_SCHED; PG8_LDA(At, 1, 0); PG8_STAGE_A(PG8_SA(0, 1), a2, cA10, cA11);
            PG8_WAIT_V(8); PG8_WAIT_L(0); PG8_BAR; PG8_MMA(0, 0, At, B0); PG8_MMA(0, 1, At, B1); PG8_BAR; PG8_SCHED;
            PG8_LDA(At, 1, 1); PG8_STAGE_B(PG8_SB(1, 0), b03); PG8_STAGE_B(PG8_SB(1, 1), b13); PG8_STAGE_A(PG8_SA(1, 0), a3, cA00, cA01);
            PG8_WAIT_V(8); PG8_WAIT_L(0); PG8_BAR; PG8_MMA(1, 0, At, B0); PG8_MMA(1, 1, At, B1); PG8_BAR; PG8_SCHED;
        }
        if (wr == 0) PG8_BAR;
        { const int lz = lane_id_opaque();
          E(acc, cur, wr, wc, lz & 15, lz >> 4, lds); }
        if (!has_next) break;
#pragma unroll
        for (int a = 0; a < 2; ++a)
#pragma unroll
            for (int b = 0; b < 2; ++b)
#pragma unroll
                for (int m = 0; m < 4; ++m)
#pragma unroll
                    for (int n = 0; n < 2; ++n) acc[a][b][m][n] = (f32x4){0.f, 0.f, 0.f, 0.f};
        cur = nxt; cA = nA; cB0 = nB0; cB1 = nB1; ++ui;
        if (wr == 1) PG8_BAR;
    }
    PG8_WAIT_V(0);
    PG8_BAR;
#undef PG8_SA
#undef PG8_SB
#undef PG8_LD1
#undef PG8_STAGE_A
#undef PG8_STAGE_B
#undef PG8_LDA
#undef PG8_LDB
#undef PG8_MMA
#undef PG8_WAIT_V
#undef PG8_WAIT_L
#undef PG8_BAR
#undef PG8_SCHED
}
}

#define XB_TMO      128
#define XB_XCNT(j)  (256  + 64 * (j))
#define XB_XSUB(j)  (1280 + 64 * (j))
#define XB_XGEN(j)  (2304 + 64 * (j))
#define XB_TOP      3328
#define XB_TOPGEN   3392
#define XCD_BAR_WORDS 3456
#define XB_SPIN_CAP (1u << 18)
__device__ __forceinline__ unsigned xb_ld(unsigned* p)              { return __hip_atomic_load(p, __ATOMIC_RELAXED, __HIP_MEMORY_SCOPE_AGENT); }
__device__ __forceinline__ unsigned xb_add(unsigned* p, unsigned v) { return __hip_atomic_fetch_add(p, v, __ATOMIC_RELAXED, __HIP_MEMORY_SCOPE_AGENT); }
__device__ __forceinline__ unsigned xb_xcc_id() { return (unsigned)__builtin_amdgcn_s_getreg((3 << 11) | 20) & 0xFu; }
#define XB_SPIN(cond, bar) do { unsigned _sp = 0; while (cond) { __builtin_amdgcn_s_sleep(1); \
    if ((++_sp & 255u) == 0u) { if (xb_ld(&(bar)[XB_TMO])) break; if (_sp > XB_SPIN_CAP) { atomicAdd(&(bar)[XB_TMO], 1u); break; } } } } while (0)
struct XcdBarrier { unsigned* bar; unsigned x; volatile LAS unsigned* st; };
__device__ __forceinline__ XcdBarrier xcd_barrier_post(unsigned* bar, volatile LAS unsigned* st) {
    XcdBarrier b; b.bar = bar; b.x = xb_xcc_id(); b.st = st;
    if (threadIdx.x == 0) (void)xb_add(&bar[XB_XCNT(b.x)], 1u);
    return b;
}
__device__ __forceinline__ void xcd_barrier_complete(unsigned* bar, unsigned x, unsigned& nloc, unsigned& nx) {
    const unsigned G = gridDim.x * gridDim.y * gridDim.z;
    unsigned sum, cnt, mine, sp = 0u;
    for (;;) {
        sum = 0u; cnt = 0u; mine = 0u;
#pragma unroll
        for (unsigned j = 0; j < 16; ++j) { const unsigned c = xb_ld(&bar[XB_XCNT(j)]); sum += c; cnt += (c > 0u) ? 1u : 0u; mine = (j == x) ? c : mine; }
        if (sum == G) break;
        __builtin_amdgcn_s_sleep(1);
        if ((++sp & 255u) == 0u) { if (xb_ld(&bar[XB_TMO])) break; if (sp > XB_SPIN_CAP) { atomicAdd(&bar[XB_TMO], 1u); break; } }
    }
    nloc = mine > 0u ? mine : 1u; nx = cnt > 0u ? cnt : 1u;
}
__device__ __forceinline__ void xcd_barrier(const XcdBarrier& b, const int wave) {
    asm volatile("s_waitcnt vmcnt(0)" ::: "memory");
    __syncthreads();
    if (wave == 0 && lane_id_opaque() == 0) {
        unsigned* bar = b.bar;
        __builtin_amdgcn_s_waitcnt(0);
        unsigned nloc = b.st[0], nx = b.st[1];
        if (nloc == 0u) { xcd_barrier_complete(bar, b.x, nloc, nx); b.st[0] = nloc; b.st[1] = nx; }
        const unsigned old = xb_add(&bar[XB_XSUB(b.x)], 1u);
        const unsigned gen = old / nloc;
        if (old + 1u == (gen + 1u) * nloc) {
            __builtin_amdgcn_fence(__ATOMIC_RELEASE, "agent");
            asm volatile("s_waitcnt vmcnt(0)" ::: "memory");
            const unsigned og = xb_add(&bar[XB_TOP], 1u);
            const unsigned tg = og / nx;
            if (og + 1u == (tg + 1u) * nx) xb_add(&bar[XB_TOPGEN], 1u);
            else XB_SPIN(xb_ld(&bar[XB_TOPGEN]) == tg, bar);
            __builtin_amdgcn_fence(__ATOMIC_ACQUIRE, "agent");
            xb_add(&bar[XB_XGEN(b.x)], 1u);
            asm volatile("s_waitcnt vmcnt(0)" ::: "memory");
        } else {
            XB_SPIN(xb_ld(&bar[XB_XGEN(b.x)]) == gen, bar);
            __builtin_amdgcn_fence(__ATOMIC_ACQUIRE, "agent");
            asm volatile("s_waitcnt vmcnt(0)" ::: "memory");
        }
    }
    __syncthreads();
}

struct Frame {
    LAS unsigned char* lds;
    unsigned* ctl;
    int tid, lane, wave, vcu, G;
    int xc, xs;
    const float *x, *w_in, *b_in, *conv_w, *conv_b, *conv_ln_g, *conv_ln_b, *w_out, *b_out, *ln1_g, *ln1_b, *w_router, *b_router, *w_gu, *b_gu, *w_down, *b_down, *ln2_g, *ln2_b;
    float* out;
    unsigned char* ws;
};
__device__ __forceinline__ size_t tiled8_idx(int nrows, int row, int col) { return ((size_t)(col >> 7) * nrows + row) * 128 + (col & 127); }
__device__ __forceinline__ size_t tiled_idx(int nrows, int row, int col) { return ((size_t)(col >> 6) * nrows + row) * 64 + (col & 63); }

__device__ __forceinline__ void p0_transpose_item(const float* W, int N, bf16_t* WT, LAS float* scr, int item, int lane) {
    const int nblk = N >> 6, kb = item / nblk, nb = item - kb * nblk, k0 = kb * 64, n0 = nb * 64;
    const int kr = lane >> 4, nq = lane & 15;
#pragma unroll
    for (int hh = 0; hh < 2; ++hh) {
        f32x4 v[8];
#pragma unroll
        for (int i = 0; i < 8; ++i) v[i] = *(const GAS f32x4*)(W + (size_t)(k0 + 32 * hh + 4 * i + kr) * N + n0 + 4 * nq);
#pragma unroll
        for (int i = 0; i < 8; ++i) { LAS float* s = scr + (32 * hh + 4 * i + kr) * 65 + 4 * nq; s[0] = v[i].x; s[1] = v[i].y; s[2] = v[i].z; s[3] = v[i].w; }
    }
    LDS_WAIT(); asm volatile("" ::: "memory");
    const int c = lane & 7;
#pragma unroll
    for (int j = 0; j < 8; ++j) { const int n = 8 * j + (lane >> 3); const LAS float* s = scr + (8 * c) * 65 + n;
        u32x4 o; o.x = cvt_pk_bf16(s[0 * 65], s[1 * 65]); o.y = cvt_pk_bf16(s[2 * 65], s[3 * 65]); o.z = cvt_pk_bf16(s[4 * 65], s[5 * 65]); o.w = cvt_pk_bf16(s[6 * 65], s[7 * 65]);
        *(GAS u32x4*)(WT + ((size_t)kb * N + n0 + n) * 64 + 8 * c) = o; }
    LDS_WAIT(); asm volatile("" ::: "memory");
}
constexpr int MOE_I_GU = 16 * (2 * FF / 64), MOE_I_DN = 16 * (D / 64), MOE_N_GU = NE * MOE_I_GU, MOE_N_ALL = MOE_N_GU + NE * MOE_I_DN;
__device__ __forceinline__ int moe_rounds(int G) { return (MOE_N_ALL + G * 8 - 1) / (G * 8); }
struct MoeItem { const float* W; unsigned char* WT; int N; float rscale; unsigned woff; int isdn; };
__device__ __forceinline__ MoeItem moe_item(Frame& F, int j) {
    int vc = F.vcu;
    if (F.G == 256 && j >= 24) { const int x = F.xc + (j - 24) * F.xs, hb = x >> 3; j = 16 + (x & 7); vc = (hb & 7) * 32 + (hb >> 3); }
    const int pv = (F.G == 256) ? (((vc >> 5) * 4 + (vc & 3)) * 8 + ((vc >> 2) & 7)) : vc;
    MoeItem m; int it = (j * F.G + pv) * 8 + F.wave; if (it >= MOE_N_ALL) it -= MOE_N_ALL;
    if (it < MOE_N_GU) { const int e = it / MOE_I_GU, r = it - e * MOE_I_GU; const int nblk = (2 * FF) >> 6, kb = r / nblk, nb = r - kb * nblk; m.N = 2 * FF; m.rscale = 1.0f / WGU_SCALE;
        m.W = F.w_gu + (size_t)e * D * 2 * FF + (size_t)(kb * 128) * (2 * FF) + nb * 64; m.woff = (unsigned)(((size_t)e * D * 2 * FF + (size_t)(kb * 128) * (2 * FF) + nb * 64) * 4); m.isdn = 0; m.WT = F.ws + WS_WGU + (size_t)e * D * 2 * FF + ((size_t)kb * (2 * FF) + nb * 64) * 128; }
    else { const int q = it - MOE_N_GU; const int e = q / MOE_I_DN, r = q - e * MOE_I_DN; const int nblk = D >> 6, kb = r / nblk, nb = r - kb * nblk; m.N = D; m.rscale = 1.0f / WD_SCALE;
        m.W = F.w_down + (size_t)e * FF * D + (size_t)(kb * 128) * D + nb * 64; m.woff = (unsigned)(((size_t)e * FF * D + (size_t)(kb * 128) * D + nb * 64) * 4); m.isdn = 1; m.WT = F.ws + WS_WD + (size_t)e * FF * D + ((size_t)kb * D + nb * 64) * 128; }
    return m;
}
#define MOE_LOADS(m) do { const unsigned lo_ = (unsigned)((16 * kq * (m).N + 4 * nq) * 4); \
        _Pragma("unroll") for (int h = 0; h < 2; ++h) _Pragma("unroll") for (int ii = 0; ii < 4; ++ii) _Pragma("unroll") for (int jj = 0; jj < 4; ++jj) \
        v[h][ii][jj] = __builtin_bit_cast(f32x4, __builtin_amdgcn_raw_buffer_load_b128((m).isdn ? rsdn : rsgu, (int)lo_, (int)((m).woff + (unsigned)((64 * h + 4 * ii + jj) * (m).N * 4)), MOE_LD_AUX)); } while (0)
#define MOE_CVT(m) do { _Pragma("unroll") for (int h = 0; h < 2; ++h) _Pragma("unroll") for (int c = 0; c < 4; ++c) { u32x4 w_; \
        _Pragma("unroll") for (int ii = 0; ii < 4; ++ii) { v2s_t p_ = {0, 0}; p_ = __builtin_amdgcn_cvt_scalef32_pk_fp8_f32(p_, v[h][ii][0][c], v[h][ii][1][c], (m).rscale, false); \
            p_ = __builtin_amdgcn_cvt_scalef32_pk_fp8_f32(p_, v[h][ii][2][c], v[h][ii][3][c], (m).rscale, true); w_[ii] = __builtin_bit_cast(unsigned, p_); } \
        *(LAS u32x4*)(scr + (17 * c + nq) * 144 + 16 * (4 * h + kq)) = w_; } \
        LDS_WAIT(); asm volatile("" ::: "memory"); \
        _Pragma("unroll") for (int p = 0; p < 8; ++p) { const int n_ = 8 * p + (lane >> 3); o[p] = *(const LAS u32x4*)(scr + (17 * (n_ & 3) + (n_ >> 2)) * 144 + 16 * (lane & 7)); } \
        LDS_WAIT(); asm volatile("" ::: "memory"); } while (0)
#define MOE_STORES(m) do { const unsigned so_ = (unsigned)((lane >> 3) * 128 + 16 * (lane & 7)); \
        _Pragma("unroll") for (int p = 0; p < 8; ++p) __builtin_nontemporal_store(o[p], (GAS u32x4*)((GAS unsigned char*)((m).WT + p * 1024) + so_)); } while (0)
__device__ __forceinline__ void moe_convert(Frame& F, int j_lo, int j_hi) {
    if (j_lo < j_hi) {
        LAS unsigned char* scr = F.lds + F.wave * 9792;
        const int lane = F.lane, kq = lane >> 4, nq = lane & 15;
        const rsrc_t rsgu = __builtin_amdgcn_make_buffer_rsrc((void*)F.w_gu, 0, NE * D * 2 * FF * 4, 0x00020000), rsdn = __builtin_amdgcn_make_buffer_rsrc((void*)F.w_down, 0, NE * FF * D * 4, 0x00020000);
        f32x4 v[2][4][4]; u32x4 o[8];
        MoeItem cur = moe_item(F, j_lo);
        MOE_LOADS(cur);
        for (int j = j_lo; j + 1 < j_hi; ++j) {
            const MoeItem nxt = moe_item(F, j + 1);
            MOE_CVT(cur);
            MOE_LOADS(nxt);
            MOE_STORES(cur);
            cur = nxt;
        }
        MOE_CVT(cur);
        MOE_STORES(cur);
    }
    LDS_WAIT(); __syncthreads();
}
#undef MOE_LOADS
#undef MOE_CVT
#undef MOE_STORES
__device__ __forceinline__ void p0_prologue(Frame& F) {
    LAS float* scr = (LAS float*)(F.lds + F.wave * 16640);
    const int gw = F.vcu * 8 + F.wave, NGW = F.G * 8;
    constexpr int I_IN = 32 * (NPROJ / 64), I_OUT = 32 * (D / 64);
    constexpr int NITEMS = I_IN + I_OUT;
    for (int it = gw; it < NITEMS; it += NGW) {
        if (it < I_IN) p0_transpose_item(F.w_in, NPROJ, (bf16_t*)(F.ws + WS_WIN), scr, it, F.lane);
        else p0_transpose_item(F.w_out, D, (bf16_t*)(F.ws + WS_WOUT), scr, it - I_IN, F.lane);
    }
    bf16_t* XT = (bf16_t*)(F.ws + WS_XT);
    for (int m = gw; m < NTOK; m += NGW) {
        const GAS f32x4* xr = (const GAS f32x4*)(F.x + (size_t)m * D) + F.lane;
#pragma unroll
        for (int j = 0; j < 8; ++j) { const f32x4 v = xr[64 * j]; const int col = 256 * j + 4 * F.lane;
            u32x2 o; o.x = cvt_pk_bf16(v.x, v.y); o.y = cvt_pk_bf16(v.z, v.w); *(GAS u32x2*)(XT + tiled_idx(NTOK, m, col)) = o; }
    }
    float* COS = (float*)(F.ws + WS_ROPE); float* SIN = COS + SEQ * 128;
    for (int idx = (F.vcu * 512 + F.tid); idx < SEQ * 128; idx += F.G * 512) {
        const int pos = idx >> 7, i = idx & 127;
        const float invf = powf(10000.0f, -(float)i / 128.0f);
        const float angf = (float)pos * invf;
        const double a = (double)angf;
        const double n = __builtin_rint(a * 0.6366197723675814);
        const double r = __builtin_fma(-n, 6.123233995736766e-17, __builtin_fma(-n, 1.5707963267948966, a));
        const double r2 = r * r;
        double sp = -7.647163731819816e-13; sp = sp * r2 + 1.6059043836821613e-10; sp = sp * r2 - 2.505210838544172e-08; sp = sp * r2 + 2.7557319223985893e-06; sp = sp * r2 - 1.984126984126984e-04; sp = sp * r2 + 8.333333333333333e-03; sp = sp * r2 - 1.6666666666666666e-01;
        const double sr = r + r * r2 * sp;
        double cp = 4.779477332387385e-14; cp = cp * r2 - 1.1470745597729725e-11; cp = cp * r2 + 2.08767569878681e-09; cp = cp * r2 - 2.755731922398589e-07; cp = cp * r2 + 2.48015873015873e-05; cp = cp * r2 - 1.388888888888889e-03; cp = cp * r2 + 4.1666666666666664e-02; cp = cp * r2 - 0.5;
        const double cr = 1.0 + r2 * cp;
        const int q = ((int)n) & 3;
        const double sv = (q == 0) ? sr : (q == 1) ? cr : (q == 2) ? -sr : -cr;
        const double cv = (q == 0) ? cr : (q == 1) ? -sr : (q == 2) ? -cr : sr;
        COS[idx] = (float)cv; SIN[idx] = (float)sv;
    }
    for (int idx = (F.vcu * 512 + F.tid); idx < NPROJ + D + NE * 2 * FF + NE * D; idx += F.G * 512) {
        if (idx < NPROJ) ((float*)(F.ws + WS_BIN))[idx] = F.b_in[idx];
        else if (idx < NPROJ + D) ((float*)(F.ws + WS_BOUT))[idx - NPROJ] = F.b_out[idx - NPROJ];
        else if (idx < NPROJ + D + NE * 2 * FF) ((float*)(F.ws + WS_BGU))[idx - NPROJ - D] = F.b_gu[idx - NPROJ - D];
        else ((float*)(F.ws + WS_BDN))[idx - NPROJ - D - NE * 2 * FF] = F.b_down[idx - NPROJ - D - NE * 2 * FF];
    }
    float* WRT = (float*)(F.ws + WS_WRT);
    for (int idx = (F.vcu * 512 + F.tid); idx < D * NE; idx += F.G * 512) { const int k = idx >> 5, e = idx & 31; WRT[e * D + k] = F.w_router[idx]; }
}

__device__ __forceinline__ void bias_prefetch(rsrc_t rs, LAS unsigned char* lds, int wid, int lane, unsigned base, int o0, int o1) {
    if (wid == 0) __builtin_amdgcn_raw_ptr_buffer_load_lds(rs, (LAS unsigned*)(lds + AUX_BIAS), 16, (int)((unsigned)(((lane >> 5) ? o1 : o0) * 4 + (lane & 31) * 16)), (int)base, 0, 0);
}
__device__ __forceinline__ f32x4 bias_ld(LAS const unsigned char* lds, int idx) { return *(const LAS f32x4*)(lds + AUX_BIAS + idx * 4); }
struct InProjOrder {
    int G, c, r_lo, r_hi;
    __device__ __forceinline__ void prep(LAS unsigned char*, int) const {}
    __device__ __forceinline__ bool next(int i, pg8::Unit& u) const {
        const int r = r_lo + i; if (r >= r_hi) return false;
        const int L = r * G + c; if (L >= 640) return false;
        const int wgid = pg8::xcd_remap(L, 640);
        const int nig = 8 * 20, gid = wgid / nig, fm = gid * 8, pm = fm + ((wgid % nig) % 8), pn = (wgid % nig) / 8;
        u.a = (unsigned)WS_XT + (unsigned)(256 * pm) * 128u; u.row0 = 256 * pm;
        int c0, c1;
        if (pn < 8) { u.kind = 0; c0 = 128 * pn; c1 = 1024 + 128 * pn; u.col0 = 128 * pn; u.e = 0; }
        else if (pn < 12) { u.kind = 1; u.e = pn - 8; c0 = 2048 + 256 * u.e; c1 = c0 + 128; u.col0 = c0; }
        else if (pn < 16) { u.kind = 2; u.e = pn - 12; c0 = 3072 + 256 * u.e; c1 = c0 + 128; u.col0 = c0; }
        else { u.kind = 3; u.e = pn - 16; c0 = 5120 + 256 * u.e; c1 = c0 + 128; u.col0 = c0; }
        u.b0 = (unsigned)WS_WIN + (unsigned)c0 * 128u; u.b1 = (unsigned)WS_WIN + (unsigned)c1 * 128u;
        return true;
    }
};
struct InProjVtOrder {
    int c;
    __device__ __forceinline__ void prep(LAS unsigned char*, int) const {}
    __device__ __forceinline__ bool next(int i, pg8::Unit& u) const {
        if (i != 0 || c < 128) return false;
        const int L = c - 128, pm = L & 3, pn = L >> 2;
        u.a = (unsigned)WS_WIN + (unsigned)(4096 + 256 * pm) * 128u; u.row0 = 256 * pm; u.col0 = 256 * pn; u.kind = 4; u.e = 0;
        u.b0 = (unsigned)WS_XT + (unsigned)(256 * pn) * 128u; u.b1 = u.b0 + 128u * 128u;
        return true;
    }
};
struct EpiInProj {
    unsigned char* wp;
    __device__ __forceinline__ void prefetch(const pg8::Unit& u, int wid, int lane, LAS unsigned char* lds, rsrc_t rs) const {
        const int o0 = (u.kind == 4) ? 4096 + u.row0 : u.col0, o1 = (u.kind == 0) ? 1024 + u.col0 : o0 + 128;
        bias_prefetch(rs, lds, wid, lane, (unsigned)WS_BIN, o0, o1);
    }
    __device__ __forceinline__ void operator()(const f32x4 (&acc)[2][2][4][2], const pg8::Unit& u, int wr, int wc, int fr, int fq, LAS const unsigned char* lds) const {
        const int cr = wc * 32 + 8 * fq, lrow = wr * 64 + fr;
        if (u.kind == 0) {
            f32x4 bv[2][2];
#pragma unroll
            for (int bj = 0; bj < 2; ++bj)
#pragma unroll
                for (int n = 0; n < 2; ++n) bv[bj][n] = bias_ld(lds, bj * 128 + cr + 4 * n);
            const unsigned vo = (unsigned)((u.row0 + lrow) * 2048 + (u.col0 + cr) * 2);
#pragma unroll
            for (int ai = 0; ai < 2; ++ai)
#pragma unroll
                for (int m = 0; m < 4; ++m) {
                    float o[8];
#pragma unroll
                    for (int n = 0; n < 2; ++n)
#pragma unroll
                        for (int j = 0; j < 4; ++j) { const float v = acc[ai][0][m][n][j] + bv[0][n][j], g = acc[ai][1][m][n][j] + bv[1][n][j]; o[4 * n + j] = v * sigmoidf_(g); }
                    u32x4 w; w.x = cvt_pk_bf16(o[0], o[1]); w.y = cvt_pk_bf16(o[2], o[3]); w.z = cvt_pk_bf16(o[4], o[5]); w.w = cvt_pk_bf16(o[6], o[7]);
                    gst128(wp, w, vo, (unsigned)WS_UG + (unsigned)(ai * 128 + m * 16) * 2048u); }
        } else if (u.kind == 1 || u.kind == 2) {
            const int h = u.e; const unsigned obase = (u.kind == 1) ? (unsigned)WS_Q : (unsigned)WS_K;
            const float l2g = __log2f(1.0f - __builtin_amdgcn_exp2f(-5.0f - (float)h));
            f32x4 bv[2][2];
#pragma unroll
            for (int bj = 0; bj < 2; ++bj)
#pragma unroll
                for (int n = 0; n < 2; ++n) bv[bj][n] = bias_ld(lds, bj * 128 + cr + 4 * n);
            const unsigned vrope = (unsigned)(((u.row0 & (SEQ - 1)) + lrow) * 512 + cr * 4);
            const unsigned vo = (unsigned)((((cr >> 6) * NTOK + lrow) + (4 * h * NTOK + u.row0)) * 128 + (cr & 63) * 2);
#pragma unroll
            for (int ai = 0; ai < 2; ++ai)
#pragma unroll
                for (int m = 0; m < 4; ++m) { const int a = 16 * m + fr;
                    const float sc = (u.kind == 1) ? __builtin_amdgcn_exp2f((float)(a + 1) * l2g) : 0.0625f * __builtin_amdgcn_exp2f((float)(63 - a) * l2g);
                    float o1[8], o2[8];
#pragma unroll
                    for (int n = 0; n < 2; ++n) { const f32x4 cs = gld128f(wp, vrope + n * 16, (unsigned)WS_ROPE + (unsigned)(ai * 128 + m * 16) * 512u), sn = gld128f(wp, vrope + n * 16, (unsigned)WS_ROPE + (unsigned)(SEQ * 128 * 4) + (unsigned)(ai * 128 + m * 16) * 512u);
#pragma unroll
                        for (int j = 0; j < 4; ++j) { const float t1 = acc[ai][0][m][n][j] + bv[0][n][j], t2 = acc[ai][1][m][n][j] + bv[1][n][j];
                            o1[4 * n + j] = (t1 * cs[j] - t2 * sn[j]) * sc; o2[4 * n + j] = (t1 * sn[j] + t2 * cs[j]) * sc; } }
                    u32x4 w1, w2; w1.x = cvt_pk_bf16(o1[0], o1[1]); w1.y = cvt_pk_bf16(o1[2], o1[3]); w1.z = cvt_pk_bf16(o1[4], o1[5]); w1.w = cvt_pk_bf16(o1[6], o1[7]);
                    w2.x = cvt_pk_bf16(o2[0], o2[1]); w2.y = cvt_pk_bf16(o2[2], o2[3]); w2.z = cvt_pk_bf16(o2[4], o2[5]); w2.w = cvt_pk_bf16(o2[6], o2[7]);
                    gst128(wp, w1, vo, obase + (unsigned)(ai * 128 + m * 16) * 128u); gst128(wp, w2, vo, obase + (unsigned)(ai * 128 + m * 16) * 128u + 2u * NTOK * 128u); }
        } else if (u.kind == 3) {
            const int h = u.e;
            f32x4 bv[2][2];
#pragma unroll
            for (int bj = 0; bj < 2; ++bj)
#pragma unroll
                for (int n = 0; n < 2; ++n) bv[bj][n] = bias_ld(lds, bj * 128 + cr + 4 * n);
            const unsigned vo = (unsigned)((u.row0 + lrow) * 2048 + (256 * h + cr) * 2);
#pragma unroll
            for (int ai = 0; ai < 2; ++ai)
#pragma unroll
                for (int m = 0; m < 4; ++m) {
#pragma unroll
                    for (int bj = 0; bj < 2; ++bj) { float o[8];
#pragma unroll
                        for (int n = 0; n < 2; ++n)
#pragma unroll
                            for (int j = 0; j < 4; ++j) { const float g = acc[ai][bj][m][n][j] + bv[bj][n][j]; o[4 * n + j] = g * sigmoidf_(g); }
                        u32x4 w; w.x = cvt_pk_bf16(o[0], o[1]); w.y = cvt_pk_bf16(o[2], o[3]); w.z = cvt_pk_bf16(o[4], o[5]); w.w = cvt_pk_bf16(o[6], o[7]);
                        gst128(wp, w, vo, (unsigned)WS_G + (unsigned)(ai * 128 + m * 16) * 2048u + bj * 256u); } }
        } else {
            const unsigned vo = (unsigned)((((cr >> 6) * 1024 + lrow) + ((u.col0 >> 6) * 1024 + u.row0)) * 128 + (cr & 63) * 2);
#pragma unroll
            for (int ai = 0; ai < 2; ++ai)
#pragma unroll
                for (int m = 0; m < 4; ++m) { const float bb = *(const LAS float*)(lds + AUX_BIAS + (ai * 128 + m * 16 + lrow) * 4);
#pragma unroll
                    for (int bj = 0; bj < 2; ++bj) {
                        const f32x4 v0 = acc[ai][bj][m][0] + bb, v1 = acc[ai][bj][m][1] + bb;
                        u32x4 w; w.x = cvt_pk_bf16(v0[0], v0[1]); w.y = cvt_pk_bf16(v0[2], v0[3]); w.z = cvt_pk_bf16(v1[0], v1[1]); w.w = cvt_pk_bf16(v1[2], v1[3]);
                        gst128(wp, w, vo, (unsigned)WS_VT + (unsigned)(ai * 128 + m * 16) * 128u + (unsigned)bj * 2u * 1024u * 128u); } }
        }
    }
};

__device__ __forceinline__ void conv_unit(Frame& F, int unit) {
    const int b = unit >> 6, t0 = (unit & 63) * 32;
    const bf16_t* UG = (const bf16_t*)(F.ws + WS_UG); bf16_t* CAT = (bf16_t*)(F.ws + WS_CAT);
    LAS unsigned char* in = F.lds; LAS float* stg = (LAS float*)(F.lds + 126976);
    {
        u32x4 tv[16]; const int tid_o = F.wave * 64 + lane_id_opaque();
#pragma unroll
        for (int i = 0; i < 16; ++i) { const int c = tid_o + 512 * i, row = c >> 7, ch = c & 127, t = t0 - 30 + row;
            tv[i] = (u32x4){0u, 0u, 0u, 0u};
            if (c < 62 * 128 && t >= 0) tv[i] = *(const GAS u32x4*)(UG + (size_t)(b * SEQ + t) * CW + ch * 8); }
#pragma unroll
        for (int i = 0; i < 16; ++i) { const int c = tid_o + 512 * i, row = c >> 7, ch = c & 127;
            if (c < 62 * 128) *(LAS u32x4*)(in + row * 2048 + ch * 16) = tv[i]; }
    }
    asm volatile("" ::: "memory");
    float w0[CK], w1[CK];
#pragma unroll
    for (int k = 0; k < CK; ++k) { const f32x2 w = *(const GAS f32x2*)(F.conv_w + k * CW + 2 * F.tid); w0[k] = w.x; w1[k] = w.y; }
    const f32x2 cb = *(const GAS f32x2*)(F.conv_b + 2 * F.tid);
    f32x4 lg[4], lb[4];
#pragma unroll
    for (int j = 0; j < 4; ++j) { lg[j] = *(const GAS f32x4*)(F.conv_ln_g + 256 * j + 4 * F.lane); lb[j] = *(const GAS f32x4*)(F.conv_ln_b + 256 * j + 4 * F.lane); }
    LDS_WAIT(); __syncthreads();
    for (int blk = 0; blk < 4; ++blk) {
        float a0[8], a1[8];
#pragma unroll
        for (int tt = 0; tt < 8; ++tt) { a0[tt] = cb.x; a1[tt] = cb.y; }
#pragma unroll
        for (int rr = 0; rr < 38; ++rr) { const unsigned xv = *(const LAS unsigned*)(in + (8 * blk + rr) * 2048 + 4 * F.tid); const float x0 = bf_lo(xv), x1 = bf_hi(xv);
#pragma unroll
            for (int tt = 0; tt < 8; ++tt) { const int k = rr - tt; if (k >= 0 && k < CK) { a0[tt] += w0[k] * x0; a1[tt] += w1[k] * x1; } } }
#pragma unroll
        for (int tt = 0; tt < 8; ++tt) *(LAS f32x2*)(stg + tt * 1024 + 2 * F.tid) = (f32x2){a0[tt], a1[tt]};
        LDS_WAIT(); __syncthreads();
        {
            const int row = b * SEQ + t0 + 8 * blk + F.wave;
            f32x4 v[4]; float s = 0.f;
#pragma unroll
            for (int j = 0; j < 4; ++j) { v[j] = *(const LAS f32x4*)(stg + F.wave * 1024 + 256 * j + 4 * F.lane); s += (v[j].x + v[j].y) + (v[j].z + v[j].w); }
            const float mean = wave_sum(s) * (1.f / CW); float s2 = 0.f;
#pragma unroll
            for (int j = 0; j < 4; ++j) { v[j] = v[j] - mean; s2 += (v[j].x * v[j].x + v[j].y * v[j].y) + (v[j].z * v[j].z + v[j].w * v[j].w); }
            const float rstd = 1.0f / sqrtf(wave_sum(s2) * (1.f / CW) + LN_EPS);
#pragma unroll
            for (int j = 0; j < 4; ++j) { f32x4 y = v[j] * rstd * lg[j] + lb[j];
                y.x = y.x * sigmoidf_(y.x); y.y = y.y * sigmoidf_(y.y); y.z = y.z * sigmoidf_(y.z); y.w = y.w * sigmoidf_(y.w);
                u32x2 o; o.x = cvt_pk_bf16(y.x, y.y); o.y = cvt_pk_bf16(y.z, y.w);
                *(GAS u32x2*)(CAT + tiled_idx(NTOK, row, 256 * j + 4 * F.lane)) = o; }
        }
        LDS_WAIT(); __syncthreads();
    }
}

__device__ __forceinline__ void ret_unit(Frame& F, int unit, int pass_lo, int pass_hi) {
    using namespace pg8;
    const int bh = unit >> 4, b = bh >> 2, h = bh & 3, p = unit & 15;
    const bf16_t* Qt = (const bf16_t*)(F.ws + WS_Q); const bf16_t* Kt = (const bf16_t*)(F.ws + WS_K); const bf16_t* VT = (const bf16_t*)(F.ws + WS_VT);
    const bf16_t* Gp = (const bf16_t*)(F.ws + WS_G); bf16_t* CAT = (bf16_t*)(F.ws + WS_CAT);
    const int tid = F.tid, lane = F.lane, wid = F.wave, wq = wid >> 1, wk = wid & 1, fr = lane & 15, fq = lane >> 4;
    LAS unsigned char* lds = F.lds;
    const float l2g = __log2f(1.0f - __builtin_amdgcn_exp2f(-5.0f - (float)h));
    int R0, C0, R1, C1; stage_rc(tid * 16, R0, C0); stage_rc(tid * 16 + 8192, R1, C1);
    const int KR0 = (R0 & 32) + 8 * ((R0 & 15) >> 2) + 4 * ((R0 >> 4) & 1) + (R0 & 3);
    const unsigned ldsw = (unsigned)wid * 1024u;
    for (int pass = pass_lo; pass < pass_hi; ++pass) {
        const int qb = pass ? p : 31 - p;
        const int tok0 = b * SEQ + 64 * qb;
        bf16x8 qf[8];
#pragma unroll
        for (int ks = 0; ks < 8; ++ks) qf[ks] = *(const GAS bf16x8*)(Qt + tiled_idx(NTOK, tok0 + 16 * wq + fr, 256 * h + 32 * ks + 8 * fq));
        f32x4 o[16];
#pragma unroll
        for (int dt = 0; dt < 16; ++dt) o[dt] = (f32x4){0.f, 0.f, 0.f, 0.f};
#define RET_ISSUE(j) do { const int _buf = ((j) & 1) * 65536; const int _key0 = b * SEQ + 64 * (j); \
        _Pragma("unroll") for (int c = 0; c < 4; ++c) __builtin_amdgcn_global_load_lds((const unsigned*)(Kt + ((size_t)(4 * h + c) * NTOK + _key0 + KR0) * 64 + C0), (LAS unsigned*)(lds + _buf + c * 8192 + ldsw), 16, 0, 0); \
        _Pragma("unroll") for (int hh = 0; hh < 2; ++hh) { \
            __builtin_amdgcn_global_load_lds((const unsigned*)(VT + ((size_t)(_key0 >> 6) * 1024 + 256 * h + 128 * hh + R0) * 64 + C0), (LAS unsigned*)(lds + _buf + 32768 + hh * 16384 + ldsw), 16, 0, 0); \
            __builtin_amdgcn_global_load_lds((const unsigned*)(VT + ((size_t)(_key0 >> 6) * 1024 + 256 * h + 128 * hh + R1) * 64 + C1), (LAS unsigned*)(lds + _buf + 32768 + hh * 16384 + 8192 + ldsw), 16, 0, 0); } } while (0)
        RET_ISSUE(0);
        for (int j = 0; j <= qb; ++j) {
            VM_WAIT(); SBAR();
            if (j < qb) RET_ISSUE(j + 1);
            const int buf = (j & 1) * 65536;
            f32x4 s[2]; s[0] = (f32x4){0.f, 0.f, 0.f, 0.f}; s[1] = s[0];
#pragma unroll
            for (int ks = 0; ks < 8; ++ks)
#pragma unroll
                for (int t = 0; t < 2; ++t) { const bf16x8 kf = *(const LAS bf16x8*)(lds + buf + (ks >> 1) * 8192 + lds_byte(32 * wk + 16 * t + fr, (ks & 1) * 32 + fq * 8));
                    s[t] = __builtin_amdgcn_mfma_f32_16x16x32_bf16(kf, qf[ks], s[t], 0, 0, 0); }
            const float cdec = __builtin_amdgcn_exp2f((float)(64 * (qb - j - 1)) * l2g);
            float pv[8];
#pragma unroll
            for (int t = 0; t < 2; ++t)
#pragma unroll
                for (int r = 0; r < 4; ++r) { float v = s[t][r] * cdec; if (j == qb && (32 * wk + 8 * fq + 4 * t + r) > (16 * wq + fr)) v = 0.f; pv[4 * t + r] = v; }
            u32x4 pw; pw.x = cvt_pk_bf16(pv[0], pv[1]); pw.y = cvt_pk_bf16(pv[2], pv[3]); pw.z = cvt_pk_bf16(pv[4], pv[5]); pw.w = cvt_pk_bf16(pv[6], pv[7]);
            const bf16x8 pf = __builtin_bit_cast(bf16x8, pw);
#pragma unroll
            for (int dt = 0; dt < 16; ++dt) { const int d = 16 * dt + fr;
                const bf16x8 vf = *(const LAS bf16x8*)(lds + buf + 32768 + (d >> 7) * 16384 + lds_byte(d & 127, 32 * wk + 8 * fq));
                o[dt] = __builtin_amdgcn_mfma_f32_16x16x32_bf16(vf, pf, o[dt], 0, 0, 0); }
        }
#undef RET_ISSUE
        LDS_WAIT(); SBAR();
        LAS float* X = (LAS float*)lds;
        if (wk == 1) {
#pragma unroll
            for (int dt = 0; dt < 16; ++dt)
#pragma unroll
                for (int r = 0; r < 4; ++r) X[(wq * 64 + dt * 4 + r) * 64 + lane] = o[dt][r];
        }
        LDS_WAIT(); SBAR();
        if (wk == 0) {
            float sm = 0.f;
#pragma unroll
            for (int dt = 0; dt < 16; ++dt)
#pragma unroll
                for (int r = 0; r < 4; ++r) { o[dt][r] += X[(wq * 64 + dt * 4 + r) * 64 + lane]; sm += o[dt][r]; }
            sm += __shfl_xor(sm, 16); sm += __shfl_xor(sm, 32);
            const float mean = sm * (1.f / HD); float s2 = 0.f;
#pragma unroll
            for (int dt = 0; dt < 16; ++dt)
#pragma unroll
                for (int r = 0; r < 4; ++r) { const float dd = o[dt][r] - mean; s2 += dd * dd; }
            s2 += __shfl_xor(s2, 16); s2 += __shfl_xor(s2, 32);
            const float rstd = 1.0f / sqrtf(s2 * (1.f / HD) + LN_EPS);
            const int row = tok0 + 16 * wq + fr;
#pragma unroll
            for (int dt = 0; dt < 16; ++dt) { const int d = 16 * dt + 4 * fq;
                const u32x2 gv = *(const GAS u32x2*)(Gp + (size_t)row * 1024 + 256 * h + d);
                const float y0 = (o[dt][0] - mean) * rstd * bf_lo(gv.x), y1 = (o[dt][1] - mean) * rstd * bf_hi(gv.x), y2 = (o[dt][2] - mean) * rstd * bf_lo(gv.y), y3 = (o[dt][3] - mean) * rstd * bf_hi(gv.y);
                u32x2 w; w.x = cvt_pk_bf16(y0, y1); w.y = cvt_pk_bf16(y2, y3);
                *(GAS u32x2*)(CAT + tiled_idx(NTOK, row, 1024 + 256 * h + d)) = w; }
        }
        LDS_WAIT(); SBAR();
    }
}

struct OutProjOrder {
    int G, c;
    __device__ __forceinline__ void prep(LAS unsigned char*, int) const {}
    __device__ __forceinline__ bool next(int i, pg8::Unit& u) const {
        const int L = i * G + c; if (L >= 256) return false;
        const int wgid = pg8::xcd_remap(L, 256);
        const int nig = 8 * 8, gid = wgid / nig, fm = gid * 8, pm = fm + ((wgid % nig) % 8), pn = (wgid % nig) / 8;
        u.a = (unsigned)WS_CAT + (unsigned)(256 * pm) * 128u; u.row0 = 256 * pm; u.col0 = 256 * pn; u.kind = 0; u.e = 0;
        u.b0 = (unsigned)WS_WOUT + (unsigned)(256 * pn) * 128u; u.b1 = u.b0 + 128u * 128u;
        return true;
    }
};
struct EpiOutProj {
    unsigned char* wp; const unsigned char* xp;
    __device__ __forceinline__ void prefetch(const pg8::Unit& u, int wid, int lane, LAS unsigned char* lds, rsrc_t rs) const { bias_prefetch(rs, lds, wid, lane, (unsigned)WS_BOUT, u.col0, u.col0 + 128); }
    __device__ __forceinline__ void operator()(const f32x4 (&acc)[2][2][4][2], const pg8::Unit& u, int wr, int wc, int fr, int fq, LAS const unsigned char* lds) const {
        const int cr = wc * 32 + 8 * fq, lrow = wr * 64 + fr;
        f32x4 bv[2][2];
#pragma unroll
        for (int bj = 0; bj < 2; ++bj)
#pragma unroll
            for (int n = 0; n < 2; ++n) bv[bj][n] = bias_ld(lds, bj * 128 + cr + 4 * n);
        const unsigned vo = (unsigned)((u.row0 + lrow) * 4096 + (u.col0 + cr) * 2);
        const unsigned vx = (unsigned)((cr >> 6) * NTOK * 128 + (u.row0 + lrow) * 128 + (cr & 63) * 2) + (unsigned)(u.col0 >> 6) * (unsigned)(NTOK * 128);
#pragma unroll
        for (int ai = 0; ai < 2; ++ai)
#pragma unroll
            for (int m = 0; m < 4; ++m) {
#pragma unroll
                for (int bj = 0; bj < 2; ++bj) {
                    const u32x4 xv = __builtin_bit_cast(u32x4, gld128f(wp, vx, (unsigned)WS_XT + (unsigned)(2 * bj) * (unsigned)(NTOK * 128) + (unsigned)(ai * 128 + m * 16) * 128u));
                    const f32x4 v0 = acc[ai][bj][m][0] + bv[bj][0] + (f32x4){bf_lo(xv.x), bf_hi(xv.x), bf_lo(xv.y), bf_hi(xv.y)} * DN_ALPHA;
                    const f32x4 v1 = acc[ai][bj][m][1] + bv[bj][1] + (f32x4){bf_lo(xv.z), bf_hi(xv.z), bf_lo(xv.w), bf_hi(xv.w)} * DN_ALPHA;
                    u32x4 w; w.x = cvt_pk_bf16(v0[0], v0[1]); w.y = cvt_pk_bf16(v0[2], v0[3]); w.z = cvt_pk_bf16(v1[0], v1[1]); w.w = cvt_pk_bf16(v1[2], v1[3]);
                    gst128(wp, w, vo, (unsigned)WS_PRE1 + (unsigned)(ai * 128 + m * 16) * 4096u + bj * 256u); } }
    }
};

__device__ __forceinline__ void ln1_router_tile(Frame& F, int tile) {
    const bf16_t* PRE1 = (const bf16_t*)(F.ws + WS_PRE1); bf16_t* HF = (bf16_t*)(F.ws + WS_HF); unsigned char* HB = F.ws + WS_HB;
    const float* WRT = (const float*)(F.ws + WS_WRT);
    int* ROWTOK = (int*)(F.ws + WS_ROWTOK); int* TOKE = (int*)(F.ws + WS_ASSIGN); int* TOKS = TOKE + NTOK * TOPK; float* TOKG = (float*)(TOKS + NTOK * TOPK);
    LAS float* HT = (LAS float*)F.lds;
    LAS float* RED = (LAS float*)(F.lds + 131328);
    LAS float* LG = (LAS float*)(F.lds + 131328 + 16384);
    const int lane = F.lane, w = F.wave;
    f32x4 wr0[8], wr1[8];
    { const int tk = lane & 15, kq = lane >> 4;
#pragma unroll
      for (int kg = 0; kg < 8; ++kg) { const int k0 = 256 * w + 16 * kg + 4 * kq; wr0[kg] = *(const GAS f32x4*)(WRT + (size_t)tk * D + k0); wr1[kg] = *(const GAS f32x4*)(WRT + (size_t)(tk + 16) * D + k0); } }
    const float brt = F.b_router[F.tid & 31];
#pragma unroll
    for (int tt = 0; tt < 2; ++tt) {
        const int tl = 2 * w + tt, row = tile * 16 + tl;
        const GAS u32x2* pr = (const GAS u32x2*)(PRE1 + (size_t)row * D) + lane;
        f32x4 v[8]; float s = 0.f;
#pragma unroll
        for (int j = 0; j < 8; ++j) { const u32x2 pv = pr[64 * j]; v[j] = (f32x4){bf_lo(pv.x), bf_hi(pv.x), bf_lo(pv.y), bf_hi(pv.y)}; s += (v[j].x + v[j].y) + (v[j].z + v[j].w); }
        const float mean = wave_sum(s) * (1.f / D); float s2 = 0.f;
#pragma unroll
        for (int j = 0; j < 8; ++j) { v[j] = v[j] - mean; s2 += (v[j].x * v[j].x + v[j].y * v[j].y) + (v[j].z * v[j].z + v[j].w * v[j].w); }
        const float rstd = 1.0f / sqrtf(wave_sum(s2) * (1.f / D) + LN_EPS);
#pragma unroll
        for (int j = 0; j < 8; ++j) { const int col = 256 * j + 4 * lane;
            const f32x4 g = *(const GAS f32x4*)(F.ln1_g + col), bb = *(const GAS f32x4*)(F.ln1_b + col);
            const f32x4 y = v[j] * rstd * g + bb;
            { u32x2 hb; hb.x = cvt_pk_bf16(y.x, y.y); hb.y = cvt_pk_bf16(y.z, y.w); *(GAS u32x2*)(HF + (size_t)row * D + col) = hb; }
            int o = __builtin_amdgcn_cvt_pk_fp8_f32(y.x, y.y, 0, false); o = __builtin_amdgcn_cvt_pk_fp8_f32(y.z, y.w, o, true);
            *(GAS int*)(HB + tiled8_idx(NTOK, row, col)) = o;
            *(LAS f32x4*)(HT + tl * 2052 + col) = y; }
    }
    LDS_WAIT(); __syncthreads();
    {
        const int tk = lane & 15, kq = lane >> 4;
        f32x4 a0 = (f32x4){0.f, 0.f, 0.f, 0.f}, a1 = a0;
        f32x4 ws0[8], ws1[8];
#pragma unroll
        for (int kg = 0; kg < 8; ++kg) { const int k0 = 256 * w + 16 * (kg + 8) + 4 * kq; ws0[kg] = *(const GAS f32x4*)(WRT + (size_t)tk * D + k0); ws1[kg] = *(const GAS f32x4*)(WRT + (size_t)(tk + 16) * D + k0); }
#pragma unroll
        for (int kg = 0; kg < 16; ++kg) { const int k0 = 256 * w + 16 * kg + 4 * kq;
            const f32x4 hv = *(const LAS f32x4*)(HT + tk * 2052 + k0);
            const f32x4 w0 = (kg < 8) ? wr0[kg & 7] : ws0[kg & 7], w1 = (kg < 8) ? wr1[kg & 7] : ws1[kg & 7];
#pragma unroll
            for (int i = 0; i < 4; ++i) { a0 = __builtin_amdgcn_mfma_f32_16x16x4f32(hv[i], w0[i], a0, 0, 0, 0); a1 = __builtin_amdgcn_mfma_f32_16x16x4f32(hv[i], w1[i], a1, 0, 0, 0); } }
#pragma unroll
        for (int r = 0; r < 4; ++r) { RED[(w * 16 + 4 * kq + r) * 32 + tk] = a0[r]; RED[(w * 16 + 4 * kq + r) * 32 + 16 + tk] = a1[r]; }
    }
    LDS_WAIT(); __syncthreads();
    { const int t = F.tid >> 5, e = F.tid & 31; float sum = brt;
#pragma unroll
        for (int ww = 0; ww < 8; ++ww) sum += RED[(ww * 16 + t) * 32 + e];
        LG[t * 32 + e] = sum; }
    LDS_WAIT(); __syncthreads();
    LAS unsigned* LC = (LAS unsigned*)(F.lds + 131328 + 16384 + 2048);
    if (F.tid < 32) LC[F.tid] = 0u;
    LDS_WAIT(); __syncthreads();
    int ti[4] = {0, 0, 0, 0}; int ls[4] = {0, 0, 0, 0}; float gt[4] = {0.f, 0.f, 0.f, 0.f};
    if (F.tid < 16) {
        float lv[32];
#pragma unroll
        for (int e = 0; e < 32; ++e) lv[e] = LG[F.tid * 32 + e];
        float tv[4];
#pragma unroll
        for (int k = 0; k < 4; ++k) { float best = -3.0e38f; int bi = 0;
#pragma unroll
            for (int e = 0; e < 32; ++e) { const bool taken = (k > 0 && ti[0] == e) || (k > 1 && ti[1] == e) || (k > 2 && ti[2] == e); if (!taken && lv[e] > best) { best = lv[e]; bi = e; } }
            tv[k] = best; ti[k] = bi; }
        const float e1 = __expf(tv[1] - tv[0]), e2 = __expf(tv[2] - tv[0]), e3 = __expf(tv[3] - tv[0]);
        const float inv = 1.0f / (1.0f + e1 + e2 + e3);
        gt[0] = inv; gt[1] = e1 * inv; gt[2] = e2 * inv; gt[3] = e3 * inv;
#pragma unroll
        for (int k = 0; k < 4; ++k) ls[k] = (int)__hip_atomic_fetch_add(LC + ti[k], 1u, __ATOMIC_RELAXED, __HIP_MEMORY_SCOPE_WORKGROUP);
    }
    LDS_WAIT(); __syncthreads();
    if (F.tid < 32) { const unsigned c = LC[F.tid]; unsigned base = 0u; if (c) base = atomicAdd(F.ctl + CW_CNT + 64 * F.tid, c); LC[32 + F.tid] = base; }
    LDS_WAIT(); __syncthreads();
    if (F.tid < 16) {
        const int tok = tile * 16 + F.tid;
#pragma unroll
        for (int k = 0; k < 4; ++k) { const int slot = (int)LC[32 + ti[k]] + ls[k];
            ROWTOK[ti[k] * NTOK + slot] = tok; TOKE[tok * 4 + k] = ti[k]; TOKS[tok * 4 + k] = slot; TOKG[tok * 4 + k] = gt[k]; }
    }
    __syncthreads();
}

__device__ __forceinline__ void build_tile_table(Frame& F) {
    LAS int* TS = (LAS int*)(F.lds + TS_OFF);
    if (F.tid < NE) TS[40 + F.tid] = (int)__hip_atomic_load(F.ctl + CW_CNT + 64 * F.tid, __ATOMIC_RELAXED, __HIP_MEMORY_SCOPE_AGENT);
    LDS_WAIT(); __syncthreads();
    if (F.tid == 0) { int acc = 0;
        for (int e = 0; e < NE; ++e) { TS[e] = acc; acc += (TS[40 + e] + 255) >> 8; }
        TS[NE] = acc; }
    LDS_WAIT(); __syncthreads();
}
struct MoeOrder {
    LAS const int* TS; const int* ROWTOK; int G, c, NT, total; unsigned wstride; int wrow_gate_up; int i0, n, built;
    __device__ __forceinline__ bool compute(int i, pg8::Unit& u, int tsl) const {
        const int L = i * G + c; if (L >= total) return false;
        const int wg = pg8::xcd_remap(L, total);
        const int mtg = wg / NT, nt = wg - mtg * NT;
        const int e = __popcll(__ballot(tsl <= mtg) & 0xffffffffull) - 1;
        u.e = e; u.kind = mtg - TS[e]; u.row0 = 256 * mtg;
        const unsigned wb = (wrow_gate_up ? (unsigned)WS_WGU : (unsigned)WS_WD) + (unsigned)e * wstride;
        if (wrow_gate_up) { u.col0 = 128 * nt; u.b0 = wb + (unsigned)(128 * nt) * 128u; u.b1 = wb + (unsigned)(FF + 128 * nt) * 128u; }
        else { u.col0 = 256 * nt; u.b0 = wb + (unsigned)(256 * nt) * 128u; u.b1 = u.b0 + 128u * 128u; }
        u.a = wrow_gate_up ? (unsigned)WS_HB : (unsigned)WS_HH + (unsigned)(256 * mtg) * 128u;
        return true;
    }
    __device__ __forceinline__ void prep(LAS unsigned char* lds, int tid) const {
        if (built) return;
        LAS int* T = (LAS int*)(lds + AUX_TOK); LAS int* UT = (LAS int*)(lds + AUX_UT);
        const int tsl = TS[tid & 31];
        int tv[12];
#pragma unroll
        for (int i = 0; i < 12; ++i) { pg8::Unit u; u.a = 0; u.b0 = 0; u.b1 = 0; u.kind = 0; u.row0 = 0; u.col0 = 0; u.e = 0; const bool ok = compute(i, u, tsl);
            if (tid == 0) { UT[i * 8 + 0] = ok ? 1 : 0; UT[i * 8 + 1] = (int)u.a; UT[i * 8 + 2] = (int)u.b0; UT[i * 8 + 3] = (int)u.b1; UT[i * 8 + 4] = u.kind; UT[i * 8 + 5] = u.row0; UT[i * 8 + 6] = u.col0; UT[i * 8 + 7] = u.e; }
            tv[i] = 0;
            if (ok && wrow_gate_up && tid < 256) { const int cnt = TS[40 + u.e], s = 256 * u.kind + tid; if (s < cnt) tv[i] = ROWTOK[u.e * NTOK + s]; } }
        if (wrow_gate_up && tid < 256) {
#pragma unroll
            for (int i = 0; i < 12; ++i) T[i * 256 + tid] = tv[i]; }
        asm volatile("s_waitcnt vmcnt(0) lgkmcnt(0)" ::: "memory"); __syncthreads();
    }
    __device__ __forceinline__ bool next(int i, pg8::Unit& u) const {
        if (i >= n || i0 + i >= 12) return false;
        LAS const int* UT = (LAS const int*)((LAS const unsigned char*)TS - TS_OFF + AUX_UT) + (i0 + i) * 8;
        const v4i_t p = *(const LAS v4i_t*)UT, q = *(const LAS v4i_t*)(UT + 4);
        if (__builtin_amdgcn_readfirstlane(p.x) == 0) return false;
        u.a = (unsigned)__builtin_amdgcn_readfirstlane(p.y); u.b0 = (unsigned)__builtin_amdgcn_readfirstlane(p.z); u.b1 = (unsigned)__builtin_amdgcn_readfirstlane(p.w);
        u.kind = __builtin_amdgcn_readfirstlane(q.x); u.row0 = __builtin_amdgcn_readfirstlane(q.y); u.col0 = __builtin_amdgcn_readfirstlane(q.z); u.e = __builtin_amdgcn_readfirstlane(q.w);
        return true;
    }
    __device__ __forceinline__ void gather(LAS const unsigned char* tab, int i, int R0, int C0, int R1, int C1, unsigned& o00, unsigned& o01, unsigned& o10, unsigned& o11) const {
        LAS const int* T = (LAS const int*)tab + (i0 + i) * 256;
        o00 = (unsigned)(T[R0] * 128 + C0 * 2); o01 = (unsigned)(T[R1] * 128 + C1 * 2); o10 = (unsigned)(T[128 + R0] * 128 + C0 * 2); o11 = (unsigned)(T[128 + R1] * 128 + C1 * 2);
    }
};
struct EpiSwiglu {
    rsrc_t rs; const float* bp; unsigned char* wp;
    __device__ __forceinline__ void prefetch(const pg8::Unit& u, int wid, int lane, LAS unsigned char* lds, rsrc_t rs_) const { bias_prefetch(rs_, lds, wid, lane, (unsigned)WS_BGU, u.e * 2 * FF + u.col0, u.e * 2 * FF + FF + u.col0); }
    __device__ __forceinline__ void operator()(const f32x4 (&acc)[2][2][4][2], const pg8::Unit& u, int wr, int wc, int fr, int fq, LAS const unsigned char* lds) const {
        const int cr = wc * 32 + 8 * fq, lrow = wr * 64 + fr;
        f32x4 bv[2][2];
#pragma unroll
        for (int bj = 0; bj < 2; ++bj)
#pragma unroll
            for (int n = 0; n < 2; ++n) bv[bj][n] = bias_ld(lds, bj * 128 + cr + 4 * n);
        const unsigned vo = (unsigned)((((u.col0 >> 7) * HROWS + u.row0) + lrow) * 128 + cr);
#pragma unroll
        for (int ai = 0; ai < 2; ++ai)
#pragma unroll
            for (int m = 0; m < 4; ++m) {
                float o[8];
#pragma unroll
                for (int n = 0; n < 2; ++n)
#pragma unroll
                    for (int j = 0; j < 4; ++j) { const float xg = fminf(acc[ai][0][m][n][j] * (1.0f / WGU_SCALE) + bv[0][n][j], 7.0f); const float xl = fminf(fmaxf(acc[ai][1][m][n][j] * (1.0f / WGU_SCALE) + bv[1][n][j], -7.0f), 7.0f);
                        o[4 * n + j] = xg * __builtin_amdgcn_rcpf(1.0f + __builtin_amdgcn_exp2f(-1.702f * 1.4426950408889634f * xg)) * (xl + 1.0f); }
                u32x2 w; int p0 = __builtin_amdgcn_cvt_pk_fp8_f32(o[0], o[1], 0, false); p0 = __builtin_amdgcn_cvt_pk_fp8_f32(o[2], o[3], p0, true);
                int p1 = __builtin_amdgcn_cvt_pk_fp8_f32(o[4], o[5], 0, false); p1 = __builtin_amdgcn_cvt_pk_fp8_f32(o[6], o[7], p1, true); w.x = (unsigned)p0; w.y = (unsigned)p1;
                gst64(wp, w, vo, (unsigned)WS_HH + (unsigned)(ai * 128 + m * 16) * 128u); }
    }
};
struct EpiDown {
    rsrc_t rs; const float* bp; unsigned char* wp;
    __device__ __forceinline__ void prefetch(const pg8::Unit& u, int wid, int lane, LAS unsigned char* lds, rsrc_t rs_) const { bias_prefetch(rs_, lds, wid, lane, (unsigned)WS_BDN, u.e * D + u.col0, u.e * D + u.col0 + 128); }
    __device__ __forceinline__ void operator()(const f32x4 (&acc)[2][2][4][2], const pg8::Unit& u, int wr, int wc, int fr, int fq, LAS const unsigned char* lds) const {
        const int cr = wc * 32 + 8 * fq, lrow = wr * 64 + fr;
        f32x4 bv[2][2];
#pragma unroll
        for (int bj = 0; bj < 2; ++bj)
#pragma unroll
            for (int n = 0; n < 2; ++n) bv[bj][n] = bias_ld(lds, bj * 128 + cr + 4 * n) * Y_SCALE;
        const unsigned vo = (unsigned)((u.row0 + lrow) * 2048 + (u.col0 + cr));
#pragma unroll
        for (int ai = 0; ai < 2; ++ai)
#pragma unroll
            for (int m = 0; m < 4; ++m) {
#pragma unroll
                for (int bj = 0; bj < 2; ++bj) { const f32x4 v0 = acc[ai][bj][m][0] * (Y_SCALE / WD_SCALE) + bv[bj][0], v1 = acc[ai][bj][m][1] * (Y_SCALE / WD_SCALE) + bv[bj][1];
                    u32x2 w; int p0 = __builtin_amdgcn_cvt_pk_fp8_f32(v0[0], v0[1], 0, false); p0 = __builtin_amdgcn_cvt_pk_fp8_f32(v0[2], v0[3], p0, true);
                    int p1 = __builtin_amdgcn_cvt_pk_fp8_f32(v1[0], v1[1], 0, false); p1 = __builtin_amdgcn_cvt_pk_fp8_f32(v1[2], v1[3], p1, true); w.x = (unsigned)p0; w.y = (unsigned)p1;
                    gst64(wp, w, vo, (unsigned)WS_Y + (unsigned)(ai * 128 + m * 16) * 2048u + bj * 128u); } }
    }
};

__device__ __forceinline__ void combine_row(Frame& F, int row) {
    const bf16_t* HF = (const bf16_t*)(F.ws + WS_HF); const unsigned char* Y = F.ws + WS_Y;
    const int* TOKE = (const int*)(F.ws + WS_ASSIGN); const int* TOKS = TOKE + NTOK * TOPK; const float* TOKG = (const float*)(TOKS + NTOK * TOPK);
    LAS const int* TS = (LAS const int*)(F.lds + TS_OFF);
    const int lane = F.lane;
    f32x4 v[8];
    const GAS u32x4* hr = (const GAS u32x4*)(HF + (size_t)row * D) + lane;
#pragma unroll
    for (int j = 0; j < 4; ++j) { const u32x4 hv = hr[64 * j]; v[2 * j] = (f32x4){bf_lo(hv.x), bf_hi(hv.x), bf_lo(hv.y), bf_hi(hv.y)} * DN_ALPHA; v[2 * j + 1] = (f32x4){bf_lo(hv.z), bf_hi(hv.z), bf_lo(hv.w), bf_hi(hv.w)} * DN_ALPHA; }
#pragma unroll
    for (int k = 0; k < 4; ++k) { const int e = TOKE[row * 4 + k], slot = TOKS[row * 4 + k]; const float g = TOKG[row * 4 + k] * (1.0f / Y_SCALE);
        const unsigned char* yr = Y + (size_t)(256 * TS[e] + slot) * D + 8 * lane;
#pragma unroll
        for (int j = 0; j < 4; ++j) { const u32x2 yv = *(const GAS u32x2*)(yr + 512 * j);
            const f32x2 a0 = __builtin_amdgcn_cvt_pk_f32_fp8((int)yv.x, false), a1 = __builtin_amdgcn_cvt_pk_f32_fp8((int)yv.x, true), a2 = __builtin_amdgcn_cvt_pk_f32_fp8((int)yv.y, false), a3 = __builtin_amdgcn_cvt_pk_f32_fp8((int)yv.y, true);
            v[2 * j].x += g * a0.x; v[2 * j].y += g * a0.y; v[2 * j].z += g * a1.x; v[2 * j].w += g * a1.y;
            v[2 * j + 1].x += g * a2.x; v[2 * j + 1].y += g * a2.y; v[2 * j + 1].z += g * a3.x; v[2 * j + 1].w += g * a3.y; } }
    float s = 0.f;
#pragma unroll
    for (int j = 0; j < 8; ++j) s += (v[j].x + v[j].y) + (v[j].z + v[j].w);
    const float mean = wave_sum(s) * (1.f / D); float s2 = 0.f;
#pragma unroll
    for (int j = 0; j < 8; ++j) { v[j] = v[j] - mean; s2 += (v[j].x * v[j].x + v[j].y * v[j].y) + (v[j].z * v[j].z + v[j].w * v[j].w); }
    const float rstd = 1.0f / sqrtf(wave_sum(s2) * (1.f / D) + LN_EPS);
#pragma unroll
    for (int j = 0; j < 8; ++j) { const int col = 512 * (j >> 1) + 8 * lane + 4 * (j & 1);
        const f32x4 g = *(const GAS f32x4*)(F.ln2_g + col), bb = *(const GAS f32x4*)(F.ln2_b + col);
        *(GAS f32x4*)(F.out + (size_t)row * D + col) = v[j] * rstd * g + bb; }
}

struct Args { const float* in[19]; float* out; unsigned char* ws; int ph_lo, ph_hi; };
__global__ void __launch_bounds__(512, 2) fwd_kernel(Args args) {
    extern __shared__ __attribute__((aligned(16))) unsigned char lds_raw[];
    Frame F;
    F.lds = (LAS unsigned char*)lds_raw;
    F.wave = __builtin_amdgcn_readfirstlane((int)threadIdx.x >> 6); F.lane = lane_id_opaque(); F.tid = F.wave * 64 + F.lane;
#define RETID() do { F.lane = lane_id_opaque(); F.tid = F.wave * 64 + F.lane; } while (0)
    F.xc = 0; F.xs = 0; F.G = gridDim.x; { const int bx = blockIdx.x; F.vcu = (F.G % 8 == 0) ? (bx % 8) * (F.G / 8) + bx / 8 : bx; }
    F.ws = args.ws; F.ctl = (unsigned*)(args.ws + WS_CTL); F.out = args.out;
    F.x = args.in[0]; F.w_in = args.in[1]; F.b_in = args.in[2]; F.conv_w = args.in[3]; F.conv_b = args.in[4]; F.conv_ln_g = args.in[5]; F.conv_ln_b = args.in[6];
    F.w_out = args.in[7]; F.b_out = args.in[8]; F.ln1_g = args.in[9]; F.ln1_b = args.in[10]; F.w_router = args.in[11]; F.b_router = args.in[12];
    F.w_gu = args.in[13]; F.b_gu = args.in[14]; F.w_down = args.in[15]; F.b_down = args.in[16]; F.ln2_g = args.in[17]; F.ln2_b = args.in[18];
    for (int u = (int)threadIdx.x; u < (LDS_BYTES - LDSCTL_OFF) / 4; u += 512) ((LAS unsigned*)(F.lds + LDSCTL_OFF))[u] = 0u;
    __syncthreads();
    XcdBarrier bar; bar.bar = F.ctl + CW_BAR; bar.x = 0; bar.st = nullptr;
    if (N_LAUNCHES == 1) bar = xcd_barrier_post(F.ctl + CW_BAR, (volatile LAS unsigned*)(F.lds + LDSCTL_OFF));
    const int lo = args.ph_lo, hi = args.ph_hi;
    unsigned long long tsa0 = 0, tsa1 = 0;
#define STAMP(p) do { if (PROBE_TS_A >= 0) { if (PROBE_TS_A == (p)) tsa0 = __builtin_amdgcn_s_memrealtime(); if (PROBE_TS_A + 1 == (p)) tsa1 = __builtin_amdgcn_s_memrealtime(); } } while (0)
    STAMP(0);
#define IN(k) (lo <= (k) && (k) < hi)
#define SEAM(k) do { if (IN(k) && IN((k) + 1)) xcd_barrier(bar, F.wave); STAMP((k) + 1); } while (0)
#define REPS(k) for (int rep_ = 0; rep_ < (((k) == PROBE_DUP && N_LAUNCHES == 1) ? 2 : 1); ++rep_)
#define REPBAR() do { if (rep_ == 0 && PROBE_DUP >= 0 && N_LAUNCHES == 1) xcd_barrier(bar, F.wave); } while (0)
    const __amdgpu_buffer_rsrc_t rs = __builtin_amdgcn_make_buffer_rsrc((void*)F.ws, 0, (int)WS_END, 0x00020000);

    if (IN(0)) { p0_prologue(F); SEAM(0); }

    const int NR = moe_rounds(F.G), r1 = (NR * 8) / 24, r2 = (NR * 10) / 24, r3 = (NR * 13) / 24, r4 = (NR * 16) / 24;

    if (IN(1)) {
        EpiInProj E{F.ws};
        const int g4 = F.vcu & 3;
        { InProjOrder S{F.G, (int)blockIdx.x, 0, g4}; pg8::gemm_phase<EpiInProj, InProjOrder, false, false>(F.lds, F.wave, S, E, rs, (unsigned)NTOK * 128u, (unsigned)NPROJ * 128u); }
        if (g4 < 3) { RETID(); moe_convert(F, 0, r1); }
        { InProjOrder S{F.G, (int)blockIdx.x, g4, 3}; pg8::gemm_phase<EpiInProj, InProjOrder, false, false>(F.lds, F.wave, S, E, rs, (unsigned)NTOK * 128u, (unsigned)NPROJ * 128u); }
        { InProjVtOrder S{(int)blockIdx.x}; pg8::gemm_phase<EpiInProj, InProjVtOrder, false, false>(F.lds, F.wave, S, E, rs, (unsigned)NPROJ * 128u, (unsigned)NTOK * 128u); }
        if (g4 == 3) { RETID(); moe_convert(F, 0, r1); }
        SEAM(1);
    }

    if (IN(2)) {
        const int g4 = F.vcu & 3;
        RETID(); if (g4 == 0) moe_convert(F, r1, r2);
        for (int u = F.vcu; u < 256; u += F.G) ret_unit(F, u, 0, 1);
        __syncthreads();
        RETID(); if (g4 == 1) moe_convert(F, r1, r2);
        for (int u = F.vcu; u < 256; u += F.G) ret_unit(F, u, 1, 2);
        __syncthreads();
        RETID(); if (g4 == 2) moe_convert(F, r1, r2);
        for (int u = F.vcu; u < 256; u += F.G) conv_unit(F, u);
        RETID(); if (g4 == 3) moe_convert(F, r1, r2);
        SEAM(2);
    }

    if (IN(3)) {
        const int g2 = F.vcu & 1;
        if (g2 == 0) { RETID(); moe_convert(F, r2, r3); }
        { OutProjOrder S{F.G, (int)blockIdx.x};
        EpiOutProj E{F.ws, (const unsigned char*)F.x};
        pg8::gemm_phase<EpiOutProj, OutProjOrder, false, false>(F.lds, F.wave, S, E, rs, (unsigned)NTOK * 128u, (unsigned)D * 128u); }
        if (g2 == 1) { RETID(); moe_convert(F, r2, r3); }
        SEAM(3);
    }

    if (IN(4)) {
        const int g3 = F.vcu % 3; int t = F.vcu;
        if (g3 == 0) { RETID(); moe_convert(F, r3, r4); }
        RETID(); if (t < NTOK / 16) { ln1_router_tile(F, t); t += F.G; }
        if (g3 == 1) { RETID(); moe_convert(F, r3, r4); }
        RETID(); for (; t < NTOK / 16; t += F.G) ln1_router_tile(F, t);
        if (g3 == 2) { RETID(); moe_convert(F, r3, r4); }
        SEAM(4);
    }

    if (IN(5) || IN(6) || IN(7)) { RETID(); build_tile_table(F); }

    if (IN(5)) { REPS(5) {
        LAS const int* TS = (LAS const int*)(F.lds + TS_OFF);
        EpiSwiglu E{rs, F.b_gu, F.ws};
        const int g4 = F.vcu & 3, isplit = 2 * g4;
        bool hole = false; int nex = 0;
        if (F.G == 256) { const int total = TS[NE] * 16, rem = total - ((total + 255) / 256 - 1) * 256, c = (int)blockIdx.x;
            if (rem <= 64) { hole = c < rem; if (!hole) { F.xc = c - rem; F.xs = 256 - rem; const int nx = 8 * rem; nex = (F.xc < nx) ? (nx - F.xc + F.xs - 1) / F.xs : 0; } } }
        { MoeOrder S{TS, (const int*)(F.ws + WS_ROWTOK), F.G, (int)blockIdx.x, 16, TS[NE] * 16, (unsigned)(D * 2 * FF), 1, 0, isplit, 0};
          pg8::gemm_phase<EpiSwiglu, MoeOrder, true, true>(F.lds, F.wave, S, E, rs, (unsigned)NTOK * 128u, (unsigned)(2 * FF) * 128u); }
        RETID(); if (!hole) moe_convert(F, r4, NR + nex);
        { MoeOrder S{TS, (const int*)(F.ws + WS_ROWTOK), F.G, (int)blockIdx.x, 16, TS[NE] * 16, (unsigned)(D * 2 * FF), 1, isplit, 12, 1};
          pg8::gemm_phase<EpiSwiglu, MoeOrder, true, true>(F.lds, F.wave, S, E, rs, (unsigned)NTOK * 128u, (unsigned)(2 * FF) * 128u); }
        if (PROBE_DUP == 5) REPBAR(); }
        SEAM(5);
    }

    if (IN(6)) { REPS(6) {
        LAS const int* TS = (LAS const int*)(F.lds + TS_OFF);
        MoeOrder S{TS, (const int*)(F.ws + WS_ROWTOK), F.G, (int)blockIdx.x, 8, TS[NE] * 8, (unsigned)(FF * D), 0, 0, 12, 0};
        EpiDown E{rs, F.b_down, F.ws};
        pg8::gemm_phase<EpiDown, MoeOrder, false, true>(F.lds, F.wave, S, E, rs, (unsigned)HROWS * 128u, (unsigned)D * 128u);
        if (PROBE_DUP == 6) REPBAR(); }
        SEAM(6);
    }

    if (IN(7)) { RETID(); REPS(7) {
        for (int m = F.vcu * 8 + F.wave; m < NTOK; m += F.G * 8) combine_row(F, m);
        if (PROBE_DUP == 7) REPBAR(); }
    }
    if (PROBE_TS_A >= 0) {
        xcd_barrier(bar, F.wave); STAMP(8);
        if (blockIdx.x == 0 && F.wave == 0) { const unsigned long long t0 = __builtin_amdgcn_s_memrealtime(), dt = (PROBE_TS_A == 99) ? 0ull : (tsa1 - tsa0); while (__builtin_amdgcn_s_memrealtime() - t0 < dt) __builtin_amdgcn_s_sleep(8); }
        xcd_barrier(bar, F.wave);
    }
#undef IN
#undef SEAM
}

extern "C" void kernel_launch(void* const* d_in, const int* in_sizes, int n_in, void* d_out, int out_size, void* d_ws, size_t ws_size, hipStream_t stream) {
    static int grid = 0;
    if (grid == 0) {
        if (n_in != 19 || out_size != NTOK * D || ws_size < WS_END) { fprintf(stderr, "kernel_launch: unexpected problem (n_in %d, out %d, ws %zu)\n", n_in, out_size, ws_size); grid = -1; return; }
        int dev = 0, cus = 0, per_cu = 0;
        if (hipGetDevice(&dev) != hipSuccess || hipDeviceGetAttribute(&cus, hipDeviceAttributeMultiprocessorCount, dev) != hipSuccess) { grid = -1; return; }
        if (hipFuncSetAttribute((const void*)fwd_kernel, hipFuncAttributeMaxDynamicSharedMemorySize, LDS_BYTES) != hipSuccess) { fprintf(stderr, "kernel_launch: hipFuncSetAttribute failed\n"); grid = -1; return; }
        if (hipOccupancyMaxActiveBlocksPerMultiprocessor(&per_cu, (const void*)fwd_kernel, 512, LDS_BYTES) != hipSuccess || per_cu < 1) fprintf(stderr, "kernel_launch: occupancy query says %d\n", per_cu);
        (void)hipGetLastError();
        grid = cus;
    }
    if (grid < 0) return;
    if (hipMemsetAsync((char*)d_ws + WS_CTL, 0, CTL_ZERO_BYTES, stream) != hipSuccess) return;
    Args a{};
    for (int i = 0; i < 19; ++i) a.in[i] = (const float*)d_in[i];
    a.out = (float*)d_out; a.ws = (unsigned char*)d_ws;
    if (N_LAUNCHES == 1) { a.ph_lo = 0; a.ph_hi = NPHASES; hipLaunchKernelGGL(fwd_kernel, dim3(grid), dim3(512), LDS_BYTES, stream, a); }
    else for (int p = 0; p < NPHASES; ++p) { a.ph_lo = p; a.ph_hi = p + 1; for (int r = 0; r < (p == PROBE_DUP ? 2 : 1); ++r) hipLaunchKernelGGL(fwd_kernel, dim3(grid), dim3(512), LDS_BYTES, stream, a); }
}
```

```cpp
#include <hip/hip_runtime.h>
#include <cstdio>
#include <cstdint>

#ifndef MK_N_LAUNCHES
#define MK_N_LAUNCHES 1
#endif
#ifndef PROBE_DUP
#define PROBE_DUP -1
#endif
#ifndef PROBE_TS_A
#define PROBE_TS_A -1
#endif

#define GAS __attribute__((address_space(1)))
#define LAS __attribute__((address_space(3)))
typedef unsigned short bf16_t;
typedef short bf16x8 __attribute__((ext_vector_type(8)));
typedef short bf16x4 __attribute__((ext_vector_type(4)));
typedef float f32x4 __attribute__((ext_vector_type(4)));
typedef float f32x2 __attribute__((ext_vector_type(2)));
typedef unsigned u32x4 __attribute__((ext_vector_type(4)));
typedef unsigned u32x2 __attribute__((ext_vector_type(2)));
typedef int v4i_t __attribute__((ext_vector_type(4)));
typedef int v8i_t __attribute__((ext_vector_type(8)));
typedef short v2s_t __attribute__((ext_vector_type(2)));

constexpr int D = 2048, NTOK = 8192, SEQ = 2048, CW = 1024, NH = 4, HD = 256, NPROJ = 6144, NE = 32, TOPK = 4, FF = 2048, CK = 31;
constexpr int HROWS = 40960;
constexpr float LN_EPS = 1e-5f;
constexpr float DN_ALPHA = 1.189207115002721f;
constexpr int NPHASES = 8;
#ifndef MOE_LD_AUX
#define MOE_LD_AUX 2
#endif
constexpr float WGU_SCALE = 32.0f, WD_SCALE = 64.0f; constexpr float Y_SCALE = 8.0f;
constexpr int N_LAUNCHES = MK_N_LAUNCHES;

constexpr size_t MiB = 1u << 20;
constexpr size_t WS_CTL = 0, CTL_ZERO_BYTES = 1 * MiB;
constexpr size_t WS_ROWTOK = 1 * MiB;
constexpr size_t WS_ASSIGN = 2 * MiB;
constexpr size_t WS_ROPE = 3 * MiB;
constexpr size_t WS_WRT = 5 * MiB;
constexpr size_t WS_BIN = 6 * MiB, WS_BOUT = WS_BIN + 32768, WS_BGU = WS_BIN + 65536, WS_BDN = WS_BGU + 524288;
constexpr size_t WS_XT = 8 * MiB;
constexpr size_t WS_WIN = 40 * MiB;
constexpr size_t WS_WOUT = 64 * MiB;
constexpr size_t WS_UG = 72 * MiB;
constexpr size_t WS_Q = 88 * MiB;
constexpr size_t WS_K = 104 * MiB;
constexpr size_t WS_VT = 120 * MiB;
constexpr size_t WS_G = 136 * MiB;
constexpr size_t WS_CAT = 152 * MiB;
constexpr size_t WS_PRE1 = 184 * MiB;
constexpr size_t WS_HF = 248 * MiB;
constexpr size_t WS_HB = 312 * MiB;
constexpr size_t WS_HH = 344 * MiB;
constexpr size_t WS_Y = 504 * MiB;
constexpr size_t WS_WGU = 672 * MiB;
constexpr size_t WS_WD = 1184 * MiB;
constexpr size_t WS_END = 1440 * MiB;
constexpr int CW_CNT = 64;
constexpr int CW_BAR = 4096;

constexpr int LDS_BYTES = 163840;
constexpr int LDSCTL_OFF = 159744;
constexpr int TS_OFF = LDSCTL_OFF + 256;
constexpr int AUX_OFF = 131072, AUX_TOK = AUX_OFF, AUX_BIAS = AUX_OFF + 12288, AUX_UT = AUX_OFF + 13312;

#define LDS_WAIT() asm volatile("s_waitcnt lgkmcnt(0)" ::: "memory")
#define VM_WAIT() asm volatile("s_waitcnt vmcnt(0)" ::: "memory")
#define SBAR() __builtin_amdgcn_s_barrier()

__device__ __forceinline__ unsigned cvt_pk_bf16(float lo, float hi) { unsigned r; asm volatile("v_cvt_pk_bf16_f32 %0, %1, %2" : "=v"(r) : "v"(lo), "v"(hi)); return r; }
__device__ __forceinline__ float bf_lo(unsigned u) { return __builtin_bit_cast(float, u << 16); }
__device__ __forceinline__ float bf_hi(unsigned u) { return __builtin_bit_cast(float, u & 0xffff0000u); }
__device__ __forceinline__ float wave_sum(float v) {
#pragma unroll
    for (int o = 1; o < 64; o <<= 1) v += __shfl_xor(v, o);
    return v;
}
__device__ __forceinline__ int lane_id_opaque() { int l; asm volatile("v_mbcnt_lo_u32_b32 %0, -1, 0\n\tv_mbcnt_hi_u32_b32 %0, -1, %0" : "=v"(l)); return l; }
__device__ __forceinline__ float sigmoidf_(float x) { return __builtin_amdgcn_rcpf(1.0f + __builtin_amdgcn_exp2f(-1.4426950408889634f * x)); }

typedef __amdgpu_buffer_rsrc_t rsrc_t;
__device__ __forceinline__ u32x4 bld128(rsrc_t r, unsigned voff, unsigned soff) { return __builtin_amdgcn_raw_buffer_load_b128(r, (int)voff, (int)soff, 0); }
__device__ __forceinline__ f32x4 bld128f(rsrc_t r, unsigned voff, unsigned soff) { return __builtin_bit_cast(f32x4, __builtin_amdgcn_raw_buffer_load_b128(r, (int)voff, (int)soff, 0)); }
__device__ __forceinline__ float bld32f(rsrc_t r, unsigned voff, unsigned soff) { return __builtin_bit_cast(float, __builtin_amdgcn_raw_buffer_load_b32(r, (int)voff, (int)soff, 0)); }
__device__ __forceinline__ void bst128(rsrc_t r, u32x4 v, unsigned voff, unsigned soff) { __builtin_amdgcn_raw_buffer_store_b128(v, r, (int)voff, (int)soff, 0); }
__device__ __forceinline__ f32x4 gld128f(const unsigned char* wp, unsigned voff, unsigned soff) { return *(const GAS f32x4*)((const GAS unsigned char*)(wp + soff) + voff); }
__device__ __forceinline__ float gld32f(const unsigned char* wp, unsigned voff, unsigned soff) { return *(const GAS float*)((const GAS unsigned char*)(wp + soff) + voff); }
__device__ __forceinline__ void gst128(unsigned char* wp, u32x4 v, unsigned voff, unsigned soff) { *(GAS u32x4*)((GAS unsigned char*)(wp + soff) + voff) = v; }
__device__ __forceinline__ void gst64(unsigned char* wp, u32x2 v, unsigned voff, unsigned soff) { *(GAS u32x2*)((GAS unsigned char*)(wp + soff) + voff) = v; }
__device__ __forceinline__ void bst64(rsrc_t r, u32x2 v, unsigned voff, unsigned soff) { __builtin_amdgcn_raw_buffer_store_b64(v, r, (int)voff, (int)soff, 0); }

namespace pg8 {
constexpr int BM = 256, BK = 64, HALF = 128, HTB = HALF * BK * 2, STAGE_BYTES = 8 * HTB;
__host__ __device__ __forceinline__ int lds_byte(int r, int c) { const int st = (r >> 4) * 2 + (c >> 5), rr = r & 15, cc = c & 31, ob = rr * 64 + cc * 2; return st * 1024 + (ob ^ (((ob >> 9) & 1) << 5)); }
__host__ __device__ __forceinline__ void stage_rc(int b, int& R, int& C) { const int st = b / 1024, sb = b % 1024, swz = sb ^ (((sb >> 9) & 1) << 5); R = (st >> 1) * 16 + swz / 64; C = (st & 1) * 32 + (swz % 64) / 2; }
__host__ __device__ __forceinline__ int perm32(int rho) { const int n = rho >> 4, i = rho & 15; return 8 * (i >> 2) + 4 * n + (i & 3); }
__host__ __device__ __forceinline__ int xcd_remap(int L, int nwg) { const int q = nwg / 8, r = nwg % 8, xcd = L % 8, off = L / 8; return (xcd < r ? xcd * (q + 1) : r * (q + 1) + (xcd - r) * q) + off; }

struct Unit { unsigned a, b0, b1; int kind, row0, col0, e; };

template <class Epi, class Sched, bool GATHER, bool FP8>
__device__ __forceinline__ void gemm_phase(LAS unsigned char* lds, const int wid, const Sched& S, const Epi& E, const __amdgpu_buffer_rsrc_t rs, const unsigned kstepA, const unsigned kstepB) {
    const int lane = lane_id_opaque(), tid = wid * 64 + lane, wr = wid >> 2, wc = wid & 3, fr = lane & 15, fq = lane >> 4;
    constexpr int nt = FP8 ? 16 : 32;
    int R0, C0, R1, C1; stage_rc(tid * 16, R0, C0); stage_rc(tid * 16 + 8192, R1, C1);
    const unsigned vB0 = (unsigned)(((R0 & ~31) + perm32(R0 & 31)) * 128 + C0 * 2), vB1 = (unsigned)(((R1 & ~31) + perm32(R1 & 31)) * 128 + C1 * 2);
    unsigned cA00, cA01, cA10, cA11;
    const unsigned ldsw = (unsigned)wid * 1024u;
    const int aoff = lds_byte(wr * 64 + fr, fq * 8), boff = lds_byte(wc * 32 + fr, fq * 8);
#define PG8_SA(b, h) (((b) * 2 + (h)) * HTB)
#define PG8_SB(b, h) ((4 + (b) * 2 + (h)) * HTB)
#define PG8_LD1(rs, bufoff, vo, so, i) __builtin_amdgcn_raw_ptr_buffer_load_lds(rs, (LAS unsigned*)(lds + (bufoff) + ldsw + (i) * 8192), 16, (int)(vo), (int)(so), 0, 0)
#define PG8_STAGE_B(bufoff, so) do { PG8_LD1(rs, bufoff, vB0, so, 0); PG8_LD1(rs, bufoff, vB1, so, 1); } while (0)
#define PG8_STAGE_A(bufoff, so, o0, o1) do { PG8_LD1(rs, bufoff, o0, so, 0); PG8_LD1(rs, bufoff, o1, so, 1); } while (0)
#define PG8_LDA(dst, b, h) do { _Pragma("unroll") for (int m = 0; m < 4; ++m) { const v4i_t _l = *(const LAS v4i_t*)(lds + PG8_SA(b, h) + aoff + m * 2048), _h = *(const LAS v4i_t*)(lds + PG8_SA(b, h) + aoff + m * 2048 + 1024); \
        dst[m] = __builtin_shufflevector(_l, _h, 0, 1, 2, 3, 4, 5, 6, 7); } } while (0)
#define PG8_LDB(dst, b, h) do { _Pragma("unroll") for (int n = 0; n < 2; ++n) { const v4i_t _l = *(const LAS v4i_t*)(lds + PG8_SB(b, h) + boff + n * 2048), _h = *(const LAS v4i_t*)(lds + PG8_SB(b, h) + boff + n * 2048 + 1024); \
        dst[n] = __builtin_shufflevector(_l, _h, 0, 1, 2, 3, 4, 5, 6, 7); } } while (0)
#define PG8_MMA(ai, bj, At, Bt) do { __builtin_amdgcn_s_setprio(1); _Pragma("unroll") for (int m = 0; m < 4; ++m) _Pragma("unroll") for (int n = 0; n < 2; ++n) { \
        if constexpr (FP8) { acc[ai][bj][m][n] = __builtin_amdgcn_mfma_scale_f32_16x16x128_f8f6f4(Bt[n], At[m], acc[ai][bj][m][n], 0, 0, 0, 0, 0, 0); }     \
        else { acc[ai][bj][m][n] = __builtin_amdgcn_mfma_f32_16x16x32_bf16(__builtin_bit_cast(bf16x8, __builtin_shufflevector(Bt[n], Bt[n], 0, 1, 2, 3)), __builtin_bit_cast(bf16x8, __builtin_shufflevector(At[m], At[m], 0, 1, 2, 3)), acc[ai][bj][m][n], 0, 0, 0); \
               acc[ai][bj][m][n] = __builtin_amdgcn_mfma_f32_16x16x32_bf16(__builtin_bit_cast(bf16x8, __builtin_shufflevector(Bt[n], Bt[n], 4, 5, 6, 7)), __builtin_bit_cast(bf16x8, __builtin_shufflevector(At[m], At[m], 4, 5, 6, 7)), acc[ai][bj][m][n], 0, 0, 0); } } \
        __builtin_amdgcn_s_setprio(0); } while (0)
#define PG8_WAIT_V(n) asm volatile("s_waitcnt vmcnt(" #n ")" ::: "memory")
#define PG8_WAIT_L(n) asm volatile("s_waitcnt lgkmcnt(" #n ")" ::: "memory")
#define PG8_BAR __builtin_amdgcn_s_barrier()
#define PG8_SCHED __builtin_amdgcn_sched_barrier(0)
    Unit cur, nxt; int ui = 0;
    S.prep(lds, tid);
    if (!S.next(0, cur)) return;
    if constexpr (GATHER) { S.gather(lds + AUX_TOK, 0, R0, C0, R1, C1, cA00, cA01, cA10, cA11); }
    else { cA00 = (unsigned)(R0 * 128 + C0 * 2); cA01 = (unsigned)(R1 * 128 + C1 * 2); cA10 = cA00 + 16384u; cA11 = cA01 + 16384u; }
    f32x4 acc[2][2][4][2];
#pragma unroll
    for (int a = 0; a < 2; ++a)
#pragma unroll
        for (int b = 0; b < 2; ++b)
#pragma unroll
            for (int m = 0; m < 4; ++m)
#pragma unroll
                for (int n = 0; n < 2; ++n) acc[a][b][m][n] = (f32x4){0.f, 0.f, 0.f, 0.f};
    v8i_t At[4], B0[2], B1[2];
    unsigned cA = cur.a, cB0 = cur.b0, cB1 = cur.b1;
    PG8_STAGE_B(PG8_SB(0, 0), cB0); PG8_STAGE_B(PG8_SB(0, 1), cB1); PG8_STAGE_A(PG8_SA(0, 0), cA, cA00, cA01); PG8_STAGE_A(PG8_SA(0, 1), cA, cA10, cA11);
    if (wr == 1) PG8_BAR;
    PG8_WAIT_V(2); PG8_BAR;
    PG8_STAGE_B(PG8_SB(1, 0), cB0 + kstepB); PG8_STAGE_A(PG8_SA(1, 0), cA + kstepA, cA00, cA01); PG8_STAGE_B(PG8_SB(1, 1), cB1 + kstepB);
    PG8_WAIT_V(6); PG8_BAR;
    for (;;) {
        const bool has_next = S.next(ui + 1, nxt);
        const unsigned nA = has_next ? nxt.a : cA, nB0 = has_next ? nxt.b0 : cB0, nB1 = has_next ? nxt.b1 : cB1;
        for (int t = 0; t < nt; t += 2) {
            const bool last = (t == nt - 2);
            const unsigned a1 = cA + (unsigned)(t + 1) * kstepA;
            const unsigned a2 = last ? nA : cA + (unsigned)(t + 2) * kstepA;
            const unsigned b02 = last ? nB0 : cB0 + (unsigned)(t + 2) * kstepB, b12 = last ? nB1 : cB1 + (unsigned)(t + 2) * kstepB;
            const unsigned a3 = a2 + kstepA, b03 = b02 + kstepB, b13 = b12 + kstepB;
            if (last) E.prefetch(cur, wid, lane_id_opaque(), lds, rs);
            PG8_LDB(B0, 0, 0); PG8_LDB(B1, 0, 1); PG8_SCHED; PG8_LDA(At, 0, 0); PG8_STAGE_A(PG8_SA(1, 1), a1, cA10, cA11);
            PG8_WAIT_V(8); PG8_WAIT_L(0); PG8_BAR; PG8_MMA(0, 0, At, B0); PG8_MMA(0, 1, At, B1); PG8_BAR; PG8_SCHED;
            if constexpr (GATHER) { if (last && has_next) S.gather(lds + AUX_TOK, ui + 1, R0, C0, R1, C1, cA00, cA01, cA10, cA11); }
            PG8_LDA(At, 0, 1); PG8_STAGE_B(PG8_SB(0, 0), b02); PG8_STAGE_B(PG8_SB(0, 1), b12); PG8_STAGE_A(PG8_SA(0, 0), a2, cA00, cA01);
            PG8_WAIT_V(8); PG8_WAIT_L(0); PG8_BAR; PG8_MMA(1, 0, At, B0); PG8_MMA(1, 1, At, B1); PG8_BAR; PG8_SCHED;
            PG8_LDB(B0, 1, 0); PG8_LDB(B1, 1, 1); PG8_SCHED; PG8_LDA(At, 1, 0); PG8_STAGE_A(PG8_SA(0, 1), a2, cA10, cA11);
            PG8_WAIT_V(8); PG8_WAIT_L(0); PG8_BAR; PG8_MMA(0, 0, At, B0); PG8_MMA(0, 1, At, B1); PG8_BAR; PG8_SCHED;
            PG8_LDA(At, 1, 1); PG8_STAGE_B(PG8_SB(1, 0), b03); PG8_STAGE_B(PG8_SB(1, 1), b13); PG8_STAGE_A(PG8_SA(1, 0), a3, cA00, cA01);
            PG8_WAIT_V(8); PG8_WAIT_L(0); PG8_BAR; PG8_MMA(1, 0, At, B0); PG8_MMA(1, 1, At, B1); PG8_BAR; PG8_SCHED;
        }
        if (wr == 0) PG8_BAR;
        { const int lz = lane_id_opaque();
          E(acc, cur, wr, wc, lz & 15, lz >> 4, lds); }
        if (!has_next) break;
#pragma unroll
        for (int a = 0; a < 2; ++a)
#pragma unroll
            for (int b = 0; b < 2; ++b)
#pragma unroll
                for (int m = 0; m < 4; ++m)
#pragma unroll
                    for (int n = 0; n < 2; ++n) acc[a][b][m][n] = (f32x4){0.f, 0.f, 0.f, 0.f};
        cur = nxt; cA = nA; cB0 = nB0; cB1 = nB1; ++ui;
        if (wr == 1) PG8_BAR;
    }
    PG8_WAIT_V(0);
    PG8_BAR;
#undef PG8_SA
#undef PG8_SB
#undef PG8_LD1
#undef PG8_STAGE_A
#undef PG8_STAGE_B
#undef PG8_LDA
#undef PG8_LDB
#undef PG8_MMA
#undef PG8_WAIT_V
#undef PG8_WAIT_L
#undef PG8_BAR
#undef PG8_SCHED
}
}

#define XB_TMO      128
#define XB_XCNT(j)  (256  + 64 * (j))
#define XB_XSUB(j)  (1280 + 64 * (j))
#define XB_XGEN(j)  (2304 + 64 * (j))
#define XB_TOP      3328
#define XB_TOPGEN   3392
#define XCD_BAR_WORDS 3456
#define XB_SPIN_CAP (1u << 18)
__device__ __forceinline__ unsigned xb_ld(unsigned* p)              { return __hip_atomic_load(p, __ATOMIC_RELAXED, __HIP_MEMORY_SCOPE_AGENT); }
__device__ __forceinline__ unsigned xb_add(unsigned* p, unsigned v) { return __hip_atomic_fetch_add(p, v, __ATOMIC_RELAXED, __HIP_MEMORY_SCOPE_AGENT); }
__device__ __forceinline__ unsigned xb_xcc_id() { return (unsigned)__builtin_amdgcn_s_getreg((3 << 11) | 20) & 0xFu; }
#define XB_SPIN(cond, bar) do { unsigned _sp = 0; while (cond) { __builtin_amdgcn_s_sleep(1); \
    if ((++_sp & 255u) == 0u) { if (xb_ld(&(bar)[XB_TMO])) break; if (_sp > XB_SPIN_CAP) { atomicAdd(&(bar)[XB_TMO], 1u); break; } } } } while (0)
struct XcdBarrier { unsigned* bar; unsigned x; volatile LAS unsigned* st; };
__device__ __forceinline__ XcdBarrier xcd_barrier_post(unsigned* bar, volatile LAS unsigned* st) {
    XcdBarrier b; b.bar = bar; b.x = xb_xcc_id(); b.st = st;
    if (threadIdx.x == 0) (void)xb_add(&bar[XB_XCNT(b.x)], 1u);
    return b;
}
__device__ __forceinline__ void xcd_barrier_complete(unsigned* bar, unsigned x, unsigned& nloc, unsigned& nx) {
    const unsigned G = gridDim.x * gridDim.y * gridDim.z;
    unsigned sum, cnt, mine, sp = 0u;
    for (;;) {
        sum = 0u; cnt = 0u; mine = 0u;
#pragma unroll
        for (unsigned j = 0; j < 16; ++j) { const unsigned c = xb_ld(&bar[XB_XCNT(j)]); sum += c; cnt += (c > 0u) ? 1u : 0u; mine = (j == x) ? c : mine; }
        if (sum == G) break;
        __builtin_amdgcn_s_sleep(1);
        if ((++sp & 255u) == 0u) { if (xb_ld(&bar[XB_TMO])) break; if (sp > XB_SPIN_CAP) { atomicAdd(&bar[XB_TMO], 1u); break; } }
    }
    nloc = mine > 0u ? mine : 1u; nx = cnt > 0u ? cnt : 1u;
}
__device__ __forceinline__ void xcd_barrier(const XcdBarrier& b, const int wave) {
    asm volatile("s_waitcnt vmcnt(0)" ::: "memory");
    __syncthreads();
    if (wave == 0 && lane_id_opaque() == 0) {
        unsigned* bar = b.bar;
        __builtin_amdgcn_s_waitcnt(0);
        unsigned nloc = b.st[0], nx = b.st[1];
        if (nloc == 0u) { xcd_barrier_complete(bar, b.x, nloc, nx); b.st[0] = nloc; b.st[1] = nx; }
        const unsigned old = xb_add(&bar[XB_XSUB(b.x)], 1u);
        const unsigned gen = old / nloc;
        if (old + 1u == (gen + 1u) * nloc) {
            __builtin_amdgcn_fence(__ATOMIC_RELEASE, "agent");
            asm volatile("s_waitcnt vmcnt(0)" ::: "memory");
            const unsigned og = xb_add(&bar[XB_TOP], 1u);
            const unsigned tg = og / nx;
            if (og + 1u == (tg + 1u) * nx) xb_add(&bar[XB_TOPGEN], 1u);
            else XB_SPIN(xb_ld(&bar[XB_TOPGEN]) == tg, bar);
            __builtin_amdgcn_fence(__ATOMIC_ACQUIRE, "agent");
            xb_add(&bar[XB_XGEN(b.x)], 1u);
            asm volatile("s_waitcnt vmcnt(0)" ::: "memory");
        } else {
            XB_SPIN(xb_ld(&bar[XB_XGEN(b.x)]) == gen, bar);
            __builtin_amdgcn_fence(__ATOMIC_ACQUIRE, "agent");
            asm volatile("s_waitcnt vmcnt(0)" ::: "memory");
        }
    }
    __syncthreads();
}

struct Frame {
    LAS unsigned char* lds;
    unsigned* ctl;
    int tid, lane, wave, vcu, G;
    int xc, xs;
    const float *x, *w_in, *b_in, *conv_w, *conv_b, *conv_ln_g, *conv_ln_b, *w_out, *b_out, *ln1_g, *ln1_b, *w_router, *b_router, *w_gu, *b_gu, *w_down, *b_down, *ln2_g, *ln2_b;
    float* out;
    unsigned char* ws;
};
__device__ __forceinline__ size_t tiled8_idx(int nrows, int row, int col) { return ((size_t)(col >> 7) * nrows + row) * 128 + (col & 127); }
__device__ __forceinline__ size_t tiled_idx(int nrows, int row, int col) { return ((size_t)(col >> 6) * nrows + row) * 64 + (col & 63); }

__device__ __forceinline__ void p0_transpose_item(const float* W, int N, bf16_t* WT, LAS float* scr, int item, int lane) {
    const int nblk = N >> 6, kb = item / nblk, nb = item - kb * nblk, k0 = kb * 64, n0 = nb * 64;
    const int kr = lane >> 4, nq = lane & 15;
#pragma unroll
    for (int hh = 0; hh < 2; ++hh) {
        f32x4 v[8];
#pragma unroll
        for (int i = 0; i < 8; ++i) v[i] = *(const GAS f32x4*)(W + (size_t)(k0 + 32 * hh + 4 * i + kr) * N + n0 + 4 * nq);
#pragma unroll
        for (int i = 0; i < 8; ++i) { LAS float* s = scr + (32 * hh + 4 * i + kr) * 65 + 4 * nq; s[0] = v[i].x; s[1] = v[i].y; s[2] = v[i].z; s[3] = v[i].w; }
    }
    LDS_WAIT(); asm volatile("" ::: "memory");
    const int c = lane & 7;
#pragma unroll
    for (int j = 0; j < 8; ++j) { const int n = 8 * j + (lane >> 3); const LAS float* s = scr + (8 * c) * 65 + n;
        u32x4 o; o.x = cvt_pk_bf16(s[0 * 65], s[1 * 65]); o.y = cvt_pk_bf16(s[2 * 65], s[3 * 65]); o.z = cvt_pk_bf16(s[4 * 65], s[5 * 65]); o.w = cvt_pk_bf16(s[6 * 65], s[7 * 65]);
        *(GAS u32x4*)(WT + ((size_t)kb * N + n0 + n) * 64 + 8 * c) = o; }
    LDS_WAIT(); asm volatile("" ::: "memory");
}
constexpr int MOE_I_GU = 16 * (2 * FF / 64), MOE_I_DN = 16 * (D / 64), MOE_N_GU = NE * MOE_I_GU, MOE_N_ALL = MOE_N_GU + NE * MOE_I_DN;
__device__ __forceinline__ int moe_rounds(int G) { return (MOE_N_ALL + G * 8 - 1) / (G * 8); }
struct MoeItem { const float* W; unsigned char* WT; int N; float rscale; unsigned woff; int isdn; };
__device__ __forceinline__ MoeItem moe_item(Frame& F, int j) {
    int vc = F.vcu;
    if (F.G == 256 && j >= 24) { const int x = F.xc + (j - 24) * F.xs, hb = x >> 3; j = 16 + (x & 7); vc = (hb & 7) * 32 + (hb >> 3); }
    const int pv = (F.G == 256) ? (((vc >> 5) * 4 + (vc & 3)) * 8 + ((vc >> 2) & 7)) : vc;
    MoeItem m; int it = (j * F.G + pv) * 8 + F.wave; if (it >= MOE_N_ALL) it -= MOE_N_ALL;
    if (it < MOE_N_GU) { const int e = it / MOE_I_GU, r = it - e * MOE_I_GU; const int nblk = (2 * FF) >> 6, kb = r / nblk, nb = r - kb * nblk; m.N = 2 * FF; m.rscale = 1.0f / WGU_SCALE;
        m.W = F.w_gu + (size_t)e * D * 2 * FF + (size_t)(kb * 128) * (2 * FF) + nb * 64; m.woff = (unsigned)(((size_t)e * D * 2 * FF + (size_t)(kb * 128) * (2 * FF) + nb * 64) * 4); m.isdn = 0; m.WT = F.ws + WS_WGU + (size_t)e * D * 2 * FF + ((size_t)kb * (2 * FF) + nb * 64) * 128; }
    else { const int q = it - MOE_N_GU; const int e = q / MOE_I_DN, r = q - e * MOE_I_DN; const int nblk = D >> 6, kb = r / nblk, nb = r - kb * nblk; m.N = D; m.rscale = 1.0f / WD_SCALE;
        m.W = F.w_down + (size_t)e * FF * D + (size_t)(kb * 128) * D + nb * 64; m.woff = (unsigned)(((size_t)e * FF * D + (size_t)(kb * 128) * D + nb * 64) * 4); m.isdn = 1; m.WT = F.ws + WS_WD + (size_t)e * FF * D + ((size_t)kb * D + nb * 64) * 128; }
    return m;
}
#define MOE_LOADS(m) do { const unsigned lo_ = (unsigned)((16 * kq * (m).N + 4 * nq) * 4); \
        _Pragma("unroll") for (int h = 0; h < 2; ++h) _Pragma("unroll") for (int ii = 0; ii < 4; ++ii) _Pragma("unroll") for (int jj = 0; jj < 4; ++jj) \
        v[h][ii][jj] = __builtin_bit_cast(f32x4, __builtin_amdgcn_raw_buffer_load_b128((m).isdn ? rsdn : rsgu, (int)lo_, (int)((m).woff + (unsigned)((64 * h + 4 * ii + jj) * (m).N * 4)), MOE_LD_AUX)); } while (0)
#define MOE_CVT(m) do { _Pragma("unroll") for (int h = 0; h < 2; ++h) _Pragma("unroll") for (int c = 0; c < 4; ++c) { u32x4 w_; \
        _Pragma("unroll") for (int ii = 0; ii < 4; ++ii) { v2s_t p_ = {0, 0}; p_ = __builtin_amdgcn_cvt_scalef32_pk_fp8_f32(p_, v[h][ii][0][c], v[h][ii][1][c], (m).rscale, false); \
            p_ = __builtin_amdgcn_cvt_scalef32_pk_fp8_f32(p_, v[h][ii][2][c], v[h][ii][3][c], (m).rscale, true); w_[ii] = __builtin_bit_cast(unsigned, p_); } \
        *(LAS u32x4*)(scr + (17 * c + nq) * 144 + 16 * (4 * h + kq)) = w_; } \
        LDS_WAIT(); asm volatile("" ::: "memory"); \
        _Pragma("unroll") for (int p = 0; p < 8; ++p) { const int n_ = 8 * p + (lane >> 3); o[p] = *(const LAS u32x4*)(scr + (17 * (n_ & 3) + (n_ >> 2)) * 144 + 16 * (lane & 7)); } \
        LDS_WAIT(); asm volatile("" ::: "memory"); } while (0)
#define MOE_STORES(m) do { const unsigned so_ = (unsigned)((lane >> 3) * 128 + 16 * (lane & 7)); \
        _Pragma("unroll") for (int p = 0; p < 8; ++p) __builtin_nontemporal_store(o[p], (GAS u32x4*)((GAS unsigned char*)((m).WT + p * 1024) + so_)); } while (0)
__device__ __forceinline__ void moe_convert(Frame& F, int j_lo, int j_hi) {
    if (j_lo < j_hi) {
        LAS unsigned char* scr = F.lds + F.wave * 9792;
        const int lane = F.lane, kq = lane >> 4, nq = lane & 15;
        const rsrc_t rsgu = __builtin_amdgcn_make_buffer_rsrc((void*)F.w_gu, 0, NE * D * 2 * FF * 4, 0x00020000), rsdn = __builtin_amdgcn_make_buffer_rsrc((void*)F.w_down, 0, NE * FF * D * 4, 0x00020000);
        f32x4 v[2][4][4]; u32x4 o[8];
        MoeItem cur = moe_item(F, j_lo);
        MOE_LOADS(cur);
        for (int j = j_lo; j + 1 < j_hi; ++j) {
            const MoeItem nxt = moe_item(F, j + 1);
            MOE_CVT(cur);
            MOE_LOADS(nxt);
            MOE_STORES(cur);
            cur = nxt;
        }
        MOE_CVT(cur);
        MOE_STORES(cur);
    }
    LDS_WAIT(); __syncthreads();
}
#undef MOE_LOADS
#undef MOE_CVT
#undef MOE_STORES
__device__ __forceinline__ void p0_prologue(Frame& F) {
    LAS float* scr = (LAS float*)(F.lds + F.wave * 16640);
    const int gw = F.vcu * 8 + F.wave, NGW = F.G * 8;
    constexpr int I_IN = 32 * (NPROJ / 64), I_OUT = 32 * (D / 64);
    constexpr int NITEMS = I_IN + I_OUT;
    for (int it = gw; it < NITEMS; it += NGW) {
        if (it < I_IN) p0_transpose_item(F.w_in, NPROJ, (bf16_t*)(F.ws + WS_WIN), scr, it, F.lane);
        else p0_transpose_item(F.w_out, D, (bf16_t*)(F.ws + WS_WOUT), scr, it - I_IN, F.lane);
    }
    bf16_t* XT = (bf16_t*)(F.ws + WS_XT);
    for (int m = gw; m < NTOK; m += NGW) {
        const GAS f32x4* xr = (const GAS f32x4*)(F.x + (size_t)m * D) + F.lane;
#pragma unroll
        for (int j = 0; j < 8; ++j) { const f32x4 v = xr[64 * j]; const int col = 256 * j + 4 * F.lane;
            u32x2 o; o.x = cvt_pk_bf16(v.x, v.y); o.y = cvt_pk_bf16(v.z, v.w); *(GAS u32x2*)(XT + tiled_idx(NTOK, m, col)) = o; }
    }
    float* COS = (float*)(F.ws + WS_ROPE); float* SIN = COS + SEQ * 128;
    for (int idx = (F.vcu * 512 + F.tid); idx < SEQ * 128; idx += F.G * 512) {
        const int pos = idx >> 7, i = idx & 127;
        const float invf = powf(10000.0f, -(float)i / 128.0f);
        const float angf = (float)pos * invf;
        const double a = (double)angf;
        const double n = __builtin_rint(a * 0.6366197723675814);
        const double r = __builtin_fma(-n, 6.123233995736766e-17, __builtin_fma(-n, 1.5707963267948966, a));
        const double r2 = r * r;
        double sp = -7.647163731819816e-13; sp = sp * r2 + 1.6059043836821613e-10; sp = sp * r2 - 2.505210838544172e-08; sp = sp * r2 + 2.7557319223985893e-06; sp = sp * r2 - 1.984126984126984e-04; sp = sp * r2 + 8.333333333333333e-03; sp = sp * r2 - 1.6666666666666666e-01;
        const double sr = r + r * r2 * sp;
        double cp = 4.779477332387385e-14; cp = cp * r2 - 1.1470745597729725e-11; cp = cp * r2 + 2.08767569878681e-09; cp = cp * r2 - 2.755731922398589e-07; cp = cp * r2 + 2.48015873015873e-05; cp = cp * r2 - 1.388888888888889e-03; cp = cp * r2 + 4.1666666666666664e-02; cp = cp * r2 - 0.5;
        const double cr = 1.0 + r2 * cp;
        const int q = ((int)n) & 3;
        const double sv = (q == 0) ? sr : (q == 1) ? cr : (q == 2) ? -sr : -cr;
        const double cv = (q == 0) ? cr : (q == 1) ? -sr : (q == 2) ? -cr : sr;
        COS[idx] = (float)cv; SIN[idx] = (float)sv;
    }
    for (int idx = (F.vcu * 512 + F.tid); idx < NPROJ + D + NE * 2 * FF + NE * D; idx += F.G * 512) {
        if (idx < NPROJ) ((float*)(F.ws + WS_BIN))[idx] = F.b_in[idx];
        else if (idx < NPROJ + D) ((float*)(F.ws + WS_BOUT))[idx - NPROJ] = F.b_out[idx - NPROJ];
        else if (idx < NPROJ + D + NE * 2 * FF) ((float*)(F.ws + WS_BGU))[idx - NPROJ - D] = F.b_gu[idx - NPROJ - D];
        else ((float*)(F.ws + WS_BDN))[idx - NPROJ - D - NE * 2 * FF] = F.b_down[idx - NPROJ - D - NE * 2 * FF];
    }
    float* WRT = (float*)(F.ws + WS_WRT);
    for (int idx = (F.vcu * 512 + F.tid); idx < D * NE; idx += F.G * 512) { const int k = idx >> 5, e = idx & 31; WRT[e * D + k] = F.w_router[idx]; }
}

__device__ __forceinline__ void bias_prefetch(rsrc_t rs, LAS unsigned char* lds, int wid, int lane, unsigned base, int o0, int o1) {
    if (wid == 0) __builtin_amdgcn_raw_ptr_buffer_load_lds(rs, (LAS unsigned*)(lds + AUX_BIAS), 16, (int)((unsigned)(((lane >> 5) ? o1 : o0) * 4 + (lane & 31) * 16)), (int)base, 0, 0);
}
__device__ __forceinline__ f32x4 bias_ld(LAS const unsigned char* lds, int idx) { return *(const LAS f32x4*)(lds + AUX_BIAS + idx * 4); }
struct InProjOrder {
    int G, c, r_lo, r_hi;
    __device__ __forceinline__ void prep(LAS unsigned char*, int) const {}
    __device__ __forceinline__ bool next(int i, pg8::Unit& u) const {
        const int r = r_lo + i; if (r >= r_hi) return false;
        const int L = r * G + c; if (L >= 640) return false;
        const int wgid = pg8::xcd_remap(L, 640);
        const int nig = 8 * 20, gid = wgid / nig, fm = gid * 8, pm = fm + ((wgid % nig) % 8), pn = (wgid % nig) / 8;
        u.a = (unsigned)WS_XT + (unsigned)(256 * pm) * 128u; u.row0 = 256 * pm;
        int c0, c1;
        if (pn < 8) { u.kind = 0; c0 = 128 * pn; c1 = 1024 + 128 * pn; u.col0 = 128 * pn; u.e = 0; }
        else if (pn < 12) { u.kind = 1; u.e = pn - 8; c0 = 2048 + 256 * u.e; c1 = c0 + 128; u.col0 = c0; }
        else if (pn < 16) { u.kind = 2; u.e = pn - 12; c0 = 3072 + 256 * u.e; c1 = c0 + 128; u.col0 = c0; }
        else { u.kind = 3; u.e = pn - 16; c0 = 5120 + 256 * u.e; c1 = c0 + 128; u.col0 = c0; }
        u.b0 = (unsigned)WS_WIN + (unsigned)c0 * 128u; u.b1 = (unsigned)WS_WIN + (unsigned)c1 * 128u;
        return true;
    }
};
struct InProjVtOrder {
    int c;
    __device__ __forceinline__ void prep(LAS unsigned char*, int) const {}
    __device__ __forceinline__ bool next(int i, pg8::Unit& u) const {
        if (i != 0 || c < 128) return false;
        const int L = c - 128, pm = L & 3, pn = L >> 2;
        u.a = (unsigned)WS_WIN + (unsigned)(4096 + 256 * pm) * 128u; u.row0 = 256 * pm; u.col0 = 256 * pn; u.kind = 4; u.e = 0;
        u.b0 = (unsigned)WS_XT + (unsigned)(256 * pn) * 128u; u.b1 = u.b0 + 128u * 128u;
        return true;
    }
};
struct EpiInProj {
    unsigned char* wp;
    __device__ __forceinline__ void prefetch(const pg8::Unit& u, int wid, int lane, LAS unsigned char* lds, rsrc_t rs) const {
        const int o0 = (u.kind == 4) ? 4096 + u.row0 : u.col0, o1 = (u.kind == 0) ? 1024 + u.col0 : o0 + 128;
        bias_prefetch(rs, lds, wid, lane, (unsigned)WS_BIN, o0, o1);
    }
    __device__ __forceinline__ void operator()(const f32x4 (&acc)[2][2][4][2], const pg8::Unit& u, int wr, int wc, int fr, int fq, LAS const unsigned char* lds) const {
        const int cr = wc * 32 + 8 * fq, lrow = wr * 64 + fr;
        if (u.kind == 0) {
            f32x4 bv[2][2];
#pragma unroll
            for (int bj = 0; bj < 2; ++bj)
#pragma unroll
                for (int n = 0; n < 2; ++n) bv[bj][n] = bias_ld(lds, bj * 128 + cr + 4 * n);
            const unsigned vo = (unsigned)((u.row0 + lrow) * 2048 + (u.col0 + cr) * 2);
#pragma unroll
            for (int ai = 0; ai < 2; ++ai)
#pragma unroll
                for (int m = 0; m < 4; ++m) {
                    float o[8];
#pragma unroll
                    for (int n = 0; n < 2; ++n)
#pragma unroll
                        for (int j = 0; j < 4; ++j) { const float v = acc[ai][0][m][n][j] + bv[0][n][j], g = acc[ai][1][m][n][j] + bv[1][n][j]; o[4 * n + j] = v * sigmoidf_(g); }
                    u32x4 w; w.x = cvt_pk_bf16(o[0], o[1]); w.y = cvt_pk_bf16(o[2], o[3]); w.z = cvt_pk_bf16(o[4], o[5]); w.w = cvt_pk_bf16(o[6], o[7]);
                    gst128(wp, w, vo, (unsigned)WS_UG + (unsigned)(ai * 128 + m * 16) * 2048u); }
        } else if (u.kind == 1 || u.kind == 2) {
            const int h = u.e; const unsigned obase = (u.kind == 1) ? (unsigned)WS_Q : (unsigned)WS_K;
            const float l2g = __log2f(1.0f - __builtin_amdgcn_exp2f(-5.0f - (float)h));
            f32x4 bv[2][2];
#pragma unroll
            for (int bj = 0; bj < 2; ++bj)
#pragma unroll
                for (int n = 0; n < 2; ++n) bv[bj][n] = bias_ld(lds, bj * 128 + cr + 4 * n);
            const unsigned vrope = (unsigned)(((u.row0 & (SEQ - 1)) + lrow) * 512 + cr * 4);
            const unsigned vo = (unsigned)((((cr >> 6) * NTOK + lrow) + (4 * h * NTOK + u.row0)) * 128 + (cr & 63) * 2);
#pragma unroll
            for (int ai = 0; ai < 2; ++ai)
#pragma unroll
                for (int m = 0; m < 4; ++m) { const int a = 16 * m + fr;
                    const float sc = (u.kind == 1) ? __builtin_amdgcn_exp2f((float)(a + 1) * l2g) : 0.0625f * __builtin_amdgcn_exp2f((float)(63 - a) * l2g);
                    float o1[8], o2[8];
#pragma unroll
                    for (int n = 0; n < 2; ++n) { const f32x4 cs = gld128f(wp, vrope + n * 16, (unsigned)WS_ROPE + (unsigned)(ai * 128 + m * 16) * 512u), sn = gld128f(wp, vrope + n * 16, (unsigned)WS_ROPE + (unsigned)(SEQ * 128 * 4) + (unsigned)(ai * 128 + m * 16) * 512u);
#pragma unroll
                        for (int j = 0; j < 4; ++j) { const float t1 = acc[ai][0][m][n][j] + bv[0][n][j], t2 = acc[ai][1][m][n][j] + bv[1][n][j];
                            o1[4 * n + j] = (t1 * cs[j] - t2 * sn[j]) * sc; o2[4 * n + j] = (t1 * sn[j] + t2 * cs[j]) * sc; } }
                    u32x4 w1, w2; w1.x = cvt_pk_bf16(o1[0], o1[1]); w1.y = cvt_pk_bf16(o1[2], o1[3]); w1.z = cvt_pk_bf16(o1[4], o1[5]); w1.w = cvt_pk_bf16(o1[6], o1[7]);
                    w2.x = cvt_pk_bf16(o2[0], o2[1]); w2.y = cvt_pk_bf16(o2[2], o2[3]); w2.z = cvt_pk_bf16(o2[4], o2[5]); w2.w = cvt_pk_bf16(o2[6], o2[7]);
                    gst128(wp, w1, vo, obase + (unsigned)(ai * 128 + m * 16) * 128u); gst128(wp, w2, vo, obase + (unsigned)(ai * 128 + m * 16) * 128u + 2u * NTOK * 128u); }
        } else if (u.kind == 3) {
            const int h = u.e;
            f32x4 bv[2][2];
#pragma unroll
            for (int bj = 0; bj < 2; ++bj)
#pragma unroll
                for (int n = 0; n < 2; ++n) bv[bj][n] = bias_ld(lds, bj * 128 + cr + 4 * n);
            const unsigned vo = (unsigned)((u.row0 + lrow) * 2048 + (256 * h + cr) * 2);
#pragma unroll
            for (int ai = 0; ai < 2; ++ai)
#pragma unroll
                for (int m = 0; m < 4; ++m) {
#pragma unroll
                    for (int bj = 0; bj < 2; ++bj) { float o[8];
#pragma unroll
                        for (int n = 0; n < 2; ++n)
#pragma unroll
                            for (int j = 0; j < 4; ++j) { const float g = acc[ai][bj][m][n][j] + bv[bj][n][j]; o[4 * n + j] = g * sigmoidf_(g); }
                        u32x4 w; w.x = cvt_pk_bf16(o[0], o[1]); w.y = cvt_pk_bf16(o[2], o[3]); w.z = cvt_pk_bf16(o[4], o[5]); w.w = cvt_pk_bf16(o[6], o[7]);
                        gst128(wp, w, vo, (unsigned)WS_G + (unsigned)(ai * 128 + m * 16) * 2048u + bj * 256u); } }
        } else {
            const unsigned vo = (unsigned)((((cr >> 6) * 1024 + lrow) + ((u.col0 >> 6) * 1024 + u.row0)) * 128 + (cr & 63) * 2);
#pragma unroll
            for (int ai = 0; ai < 2; ++ai)
#pragma unroll
                for (int m = 0; m < 4; ++m) { const float bb = *(const LAS float*)(lds + AUX_BIAS + (ai * 128 + m * 16 + lrow) * 4);
#pragma unroll
                    for (int bj = 0; bj < 2; ++bj) {
                        const f32x4 v0 = acc[ai][bj][m][0] + bb, v1 = acc[ai][bj][m][1] + bb;
                        u32x4 w; w.x = cvt_pk_bf16(v0[0], v0[1]); w.y = cvt_pk_bf16(v0[2], v0[3]); w.z = cvt_pk_bf16(v1[0], v1[1]); w.w = cvt_pk_bf16(v1[2], v1[3]);
                        gst128(wp, w, vo, (unsigned)WS_VT + (unsigned)(ai * 128 + m * 16) * 128u + (unsigned)bj * 2u * 1024u * 128u); } }
        }
    }
};

__device__ __forceinline__ void conv_unit(Frame& F, int unit) {
    const int b = unit >> 6, t0 = (unit & 63) * 32;
    const bf16_t* UG = (const bf16_t*)(F.ws + WS_UG); bf16_t* CAT = (bf16_t*)(F.ws + WS_CAT);
    LAS unsigned char* in = F.lds; LAS float* stg = (LAS float*)(F.lds + 126976);
    {
        u32x4 tv[16]; const int tid_o = F.wave * 64 + lane_id_opaque();
#pragma unroll
        for (int i = 0; i < 16; ++i) { const int c = tid_o + 512 * i, row = c >> 7, ch = c & 127, t = t0 - 30 + row;
            tv[i] = (u32x4){0u, 0u, 0u, 0u};
            if (c < 62 * 128 && t >= 0) tv[i] = *(const GAS u32x4*)(UG + (size_t)(b * SEQ + t) * CW + ch * 8); }
#pragma unroll
        for (int i = 0; i < 16; ++i) { const int c = tid_o + 512 * i, row = c >> 7, ch = c & 127;
            if (c < 62 * 128) *(LAS u32x4*)(in + row * 2048 + ch * 16) = tv[i]; }
    }
    asm volatile("" ::: "memory");
    float w0[CK], w1[CK];
#pragma unroll
    for (int k = 0; k < CK; ++k) { const f32x2 w = *(const GAS f32x2*)(F.conv_w + k * CW + 2 * F.tid); w0[k] = w.x; w1[k] = w.y; }
    const f32x2 cb = *(const GAS f32x2*)(F.conv_b + 2 * F.tid);
    f32x4 lg[4], lb[4];
#pragma unroll
    for (int j = 0; j < 4; ++j) { lg[j] = *(const GAS f32x4*)(F.conv_ln_g + 256 * j + 4 * F.lane); lb[j] = *(const GAS f32x4*)(F.conv_ln_b + 256 * j + 4 * F.lane); }
    LDS_WAIT(); __syncthreads();
    for (int blk = 0; blk < 4; ++blk) {
        float a0[8], a1[8];
#pragma unroll
        for (int tt = 0; tt < 8; ++tt) { a0[tt] = cb.x; a1[tt] = cb.y; }
#pragma unroll
        for (int rr = 0; rr < 38; ++rr) { const unsigned xv = *(const LAS unsigned*)(in + (8 * blk + rr) * 2048 + 4 * F.tid); const float x0 = bf_lo(xv), x1 = bf_hi(xv);
#pragma unroll
            for (int tt = 0; tt < 8; ++tt) { const int k = rr - tt; if (k >= 0 && k < CK) { a0[tt] += w0[k] * x0; a1[tt] += w1[k] * x1; } } }
#pragma unroll
        for (int tt = 0; tt < 8; ++tt) *(LAS f32x2*)(stg + tt * 1024 + 2 * F.tid) = (f32x2){a0[tt], a1[tt]};
        LDS_WAIT(); __syncthreads();
        {
            const int row = b * SEQ + t0 + 8 * blk + F.wave;
            f32x4 v[4]; float s = 0.f;
#pragma unroll
            for (int j = 0; j < 4; ++j) { v[j] = *(const LAS f32x4*)(stg + F.wave * 1024 + 256 * j + 4 * F.lane); s += (v[j].x + v[j].y) + (v[j].z + v[j].w); }
            const float mean = wave_sum(s) * (1.f / CW); float s2 = 0.f;
#pragma unroll
            for (int j = 0; j < 4; ++j) { v[j] = v[j] - mean; s2 += (v[j].x * v[j].x + v[j].y * v[j].y) + (v[j].z * v[j].z + v[j].w * v[j].w); }
            const float rstd = 1.0f / sqrtf(wave_sum(s2) * (1.f / CW) + LN_EPS);
#pragma unroll
            for (int j = 0; j < 4; ++j) { f32x4 y = v[j] * rstd * lg[j] + lb[j];
                y.x = y.x * sigmoidf_(y.x); y.y = y.y * sigmoidf_(y.y); y.z = y.z * sigmoidf_(y.z); y.w = y.w * sigmoidf_(y.w);
                u32x2 o; o.x = cvt_pk_bf16(y.x, y.y); o.y = cvt_pk_bf16(y.z, y.w);
                *(GAS u32x2*)(CAT + tiled_idx(NTOK, row, 256 * j + 4 * F.lane)) = o; }
        }
        LDS_WAIT(); __syncthreads();
    }
}

__device__ __forceinline__ void ret_unit(Frame& F, int unit, int pass_lo, int pass_hi) {
    using namespace pg8;
    const int bh = unit >> 4, b = bh >> 2, h = bh & 3, p = unit & 15;
    const bf16_t* Qt = (const bf16_t*)(F.ws + WS_Q); const bf16_t* Kt = (const bf16_t*)(F.ws + WS_K); const bf16_t* VT = (const bf16_t*)(F.ws + WS_VT);
    const bf16_t* Gp = (const bf16_t*)(F.ws + WS_G); bf16_t* CAT = (bf16_t*)(F.ws + WS_CAT);
    const int tid = F.tid, lane = F.lane, wid = F.wave, wq = wid >> 1, wk = wid & 1, fr = lane & 15, fq = lane >> 4;
    LAS unsigned char* lds = F.lds;
    const float l2g = __log2f(1.0f - __builtin_amdgcn_exp2f(-5.0f - (float)h));
    int R0, C0, R1, C1; stage_rc(tid * 16, R0, C0); stage_rc(tid * 16 + 8192, R1, C1);
    const int KR0 = (R0 & 32) + 8 * ((R0 & 15) >> 2) + 4 * ((R0 >> 4) & 1) + (R0 & 3);
    const unsigned ldsw = (unsigned)wid * 1024u;
    for (int pass = pass_lo; pass < pass_hi; ++pass) {
        const int qb = pass ? p : 31 - p;
        const int tok0 = b * SEQ + 64 * qb;
        bf16x8 qf[8];
#pragma unroll
        for (int ks = 0; ks < 8; ++ks) qf[ks] = *(const GAS bf16x8*)(Qt + tiled_idx(NTOK, tok0 + 16 * wq + fr, 256 * h + 32 * ks + 8 * fq));
        f32x4 o[16];
#pragma unroll
        for (int dt = 0; dt < 16; ++dt) o[dt] = (f32x4){0.f, 0.f, 0.f, 0.f};
#define RET_ISSUE(j) do { const int _buf = ((j) & 1) * 65536; const int _key0 = b * SEQ + 64 * (j); \
        _Pragma("unroll") for (int c = 0; c < 4; ++c) __builtin_amdgcn_global_load_lds((const unsigned*)(Kt + ((size_t)(4 * h + c) * NTOK + _key0 + KR0) * 64 + C0), (LAS unsigned*)(lds + _buf + c * 8192 + ldsw), 16, 0, 0); \
        _Pragma("unroll") for (int hh = 0; hh < 2; ++hh) { \
            __builtin_amdgcn_global_load_lds((const unsigned*)(VT + ((size_t)(_key0 >> 6) * 1024 + 256 * h + 128 * hh + R0) * 64 + C0), (LAS unsigned*)(lds + _buf + 32768 + hh * 16384 + ldsw), 16, 0, 0); \
            __builtin_amdgcn_global_load_lds((const unsigned*)(VT + ((size_t)(_key0 >> 6) * 1024 + 256 * h + 128 * hh + R1) * 64 + C1), (LAS unsigned*)(lds + _buf + 32768 + hh * 16384 + 8192 + ldsw), 16, 0, 0); } } while (0)
        RET_ISSUE(0);
        for (int j = 0; j <= qb; ++j) {
            VM_WAIT(); SBAR();
            if (j < qb) RET_ISSUE(j + 1);
            const int buf = (j & 1) * 65536;
            f32x4 s[2]; s[0] = (f32x4){0.f, 0.f, 0.f, 0.f}; s[1] = s[0];
#pragma unroll
            for (int ks = 0; ks < 8; ++ks)
#pragma unroll
                for (int t = 0; t < 2; ++t) { const bf16x8 kf = *(const LAS bf16x8*)(lds + buf + (ks >> 1) * 8192 + lds_byte(32 * wk + 16 * t + fr, (ks & 1) * 32 + fq * 8));
                    s[t] = __builtin_amdgcn_mfma_f32_16x16x32_bf16(kf, qf[ks], s[t], 0, 0, 0); }
            const float cdec = __builtin_amdgcn_exp2f((float)(64 * (qb - j - 1)) * l2g);
            float pv[8];
#pragma unroll
            for (int t = 0; t < 2; ++t)
#pragma unroll
                for (int r = 0; r < 4; ++r) { float v = s[t][r] * cdec; if (j == qb && (32 * wk + 8 * fq + 4 * t + r) > (16 * wq + fr)) v = 0.f; pv[4 * t + r] = v; }
            u32x4 pw; pw.x = cvt_pk_bf16(pv[0], pv[1]); pw.y = cvt_pk_bf16(pv[2], pv[3]); pw.z = cvt_pk_bf16(pv[4], pv[5]); pw.w = cvt_pk_bf16(pv[6], pv[7]);
            const bf16x8 pf = __builtin_bit_cast(bf16x8, pw);
#pragma unroll
            for (int dt = 0; dt < 16; ++dt) { const int d = 16 * dt + fr;
                const bf16x8 vf = *(const LAS bf16x8*)(lds + buf + 32768 + (d >> 7) * 16384 + lds_byte(d & 127, 32 * wk + 8 * fq));
                o[dt] = __builtin_amdgcn_mfma_f32_16x16x32_bf16(vf, pf, o[dt], 0, 0, 0); }
        }
#undef RET_ISSUE
        LDS_WAIT(); SBAR();
        LAS float* X = (LAS float*)lds;
        if (wk == 1) {
#pragma unroll
            for (int dt = 0; dt < 16; ++dt)
#pragma unroll
                for (int r = 0; r < 4; ++r) X[(wq * 64 + dt * 4 + r) * 64 + lane] = o[dt][r];
        }
        LDS_WAIT(); SBAR();
        if (wk == 0) {
            float sm = 0.f;
#pragma unroll
            for (int dt = 0; dt < 16; ++dt)
#pragma unroll
                for (int r = 0; r < 4; ++r) { o[dt][r] += X[(wq * 64 + dt * 4 + r) * 64 + lane]; sm += o[dt][r]; }
            sm += __shfl_xor(sm, 16); sm += __shfl_xor(sm, 32);
            const float mean = sm * (1.f / HD); float s2 = 0.f;
#pragma unroll
            for (int dt = 0; dt < 16; ++dt)
#pragma unroll
                for (int r = 0; r < 4; ++r) { const float dd = o[dt][r] - mean; s2 += dd * dd; }
            s2 += __shfl_xor(s2, 16); s2 += __shfl_xor(s2, 32);
            const float rstd = 1.0f / sqrtf(s2 * (1.f / HD) + LN_EPS);
            const int row = tok0 + 16 * wq + fr;
#pragma unroll
            for (int dt = 0; dt < 16; ++dt) { const int d = 16 * dt + 4 * fq;
                const u32x2 gv = *(const GAS u32x2*)(Gp + (size_t)row * 1024 + 256 * h + d);
                const float y0 = (o[dt][0] - mean) * rstd * bf_lo(gv.x), y1 = (o[dt][1] - mean) * rstd * bf_hi(gv.x), y2 = (o[dt][2] - mean) * rstd * bf_lo(gv.y), y3 = (o[dt][3] - mean) * rstd * bf_hi(gv.y);
                u32x2 w; w.x = cvt_pk_bf16(y0, y1); w.y = cvt_pk_bf16(y2, y3);
                *(GAS u32x2*)(CAT + tiled_idx(NTOK, row, 1024 + 256 * h + d)) = w; }
        }
        LDS_WAIT(); SBAR();
    }
}

struct OutProjOrder {
    int G, c;
    __device__ __forceinline__ void prep(LAS unsigned char*, int) const {}
    __device__ __forceinline__ bool next(int i, pg8::Unit& u) const {
        const int L = i * G + c; if (L >= 256) return false;
        const int wgid = pg8::xcd_remap(L, 256);
        const int nig = 8 * 8, gid = wgid / nig, fm = gid * 8, pm = fm + ((wgid % nig) % 8), pn = (wgid % nig) / 8;
        u.a = (unsigned)WS_CAT + (unsigned)(256 * pm) * 128u; u.row0 = 256 * pm; u.col0 = 256 * pn; u.kind = 0; u.e = 0;
        u.b0 = (unsigned)WS_WOUT + (unsigned)(256 * pn) * 128u; u.b1 = u.b0 + 128u * 128u;
        return true;
    }
};
struct EpiOutProj {
    unsigned char* wp; const unsigned char* xp;
    __device__ __forceinline__ void prefetch(const pg8::Unit& u, int wid, int lane, LAS unsigned char* lds, rsrc_t rs) const { bias_prefetch(rs, lds, wid, lane, (unsigned)WS_BOUT, u.col0, u.col0 + 128); }
    __device__ __forceinline__ void operator()(const f32x4 (&acc)[2][2][4][2], const pg8::Unit& u, int wr, int wc, int fr, int fq, LAS const unsigned char* lds) const {
        const int cr = wc * 32 + 8 * fq, lrow = wr * 64 + fr;
        f32x4 bv[2][2];
#pragma unroll
        for (int bj = 0; bj < 2; ++bj)
#pragma unroll
            for (int n = 0; n < 2; ++n) bv[bj][n] = bias_ld(lds, bj * 128 + cr + 4 * n);
        const unsigned vo = (unsigned)((u.row0 + lrow) * 4096 + (u.col0 + cr) * 2);
        const unsigned vx = (unsigned)((cr >> 6) * NTOK * 128 + (u.row0 + lrow) * 128 + (cr & 63) * 2) + (unsigned)(u.col0 >> 6) * (unsigned)(NTOK * 128);
#pragma unroll
        for (int ai = 0; ai < 2; ++ai)
#pragma unroll
            for (int m = 0; m < 4; ++m) {
#pragma unroll
                for (int bj = 0; bj < 2; ++bj) {
                    const u32x4 xv = __builtin_bit_cast(u32x4, gld128f(wp, vx, (unsigned)WS_XT + (unsigned)(2 * bj) * (unsigned)(NTOK * 128) + (unsigned)(ai * 128 + m * 16) * 128u));
                    const f32x4 v0 = acc[ai][bj][m][0] + bv[bj][0] + (f32x4){bf_lo(xv.x), bf_hi(xv.x), bf_lo(xv.y), bf_hi(xv.y)} * DN_ALPHA;
                    const f32x4 v1 = acc[ai][bj][m][1] + bv[bj][1] + (f32x4){bf_lo(xv.z), bf_hi(xv.z), bf_lo(xv.w), bf_hi(xv.w)} * DN_ALPHA;
                    u32x4 w; w.x = cvt_pk_bf16(v0[0], v0[1]); w.y = cvt_pk_bf16(v0[2], v0[3]); w.z = cvt_pk_bf16(v1[0], v1[1]); w.w = cvt_pk_bf16(v1[2], v1[3]);
                    gst128(wp, w, vo, (unsigned)WS_PRE1 + (unsigned)(ai * 128 + m * 16) * 4096u + bj * 256u); } }
    }
};

__device__ __forceinline__ void ln1_router_tile(Frame& F, int tile) {
    const bf16_t* PRE1 = (const bf16_t*)(F.ws + WS_PRE1); bf16_t* HF = (bf16_t*)(F.ws + WS_HF); unsigned char* HB = F.ws + WS_HB;
    const float* WRT = (const float*)(F.ws + WS_WRT);
    int* ROWTOK = (int*)(F.ws + WS_ROWTOK); int* TOKE = (int*)(F.ws + WS_ASSIGN); int* TOKS = TOKE + NTOK * TOPK; float* TOKG = (float*)(TOKS + NTOK * TOPK);
    LAS float* HT = (LAS float*)F.lds;
    LAS float* RED = (LAS float*)(F.lds + 131328);
    LAS float* LG = (LAS float*)(F.lds + 131328 + 16384);
    const int lane = F.lane, w = F.wave;
    f32x4 wr0[8], wr1[8];
    { const int tk = lane & 15, kq = lane >> 4;
#pragma unroll
      for (int kg = 0; kg < 8; ++kg) { const int k0 = 256 * w + 16 * kg + 4 * kq; wr0[kg] = *(const GAS f32x4*)(WRT + (size_t)tk * D + k0); wr1[kg] = *(const GAS f32x4*)(WRT + (size_t)(tk + 16) * D + k0); } }
    const float brt = F.b_router[F.tid & 31];
#pragma unroll
    for (int tt = 0; tt < 2; ++tt) {
        const int tl = 2 * w + tt, row = tile * 16 + tl;
        const GAS u32x2* pr = (const GAS u32x2*)(PRE1 + (size_t)row * D) + lane;
        f32x4 v[8]; float s = 0.f;
#pragma unroll
        for (int j = 0; j < 8; ++j) { const u32x2 pv = pr[64 * j]; v[j] = (f32x4){bf_lo(pv.x), bf_hi(pv.x), bf_lo(pv.y), bf_hi(pv.y)}; s += (v[j].x + v[j].y) + (v[j].z + v[j].w); }
        const float mean = wave_sum(s) * (1.f / D); float s2 = 0.f;
#pragma unroll
        for (int j = 0; j < 8; ++j) { v[j] = v[j] - mean; s2 += (v[j].x * v[j].x + v[j].y * v[j].y) + (v[j].z * v[j].z + v[j].w * v[j].w); }
        const float rstd = 1.0f / sqrtf(wave_sum(s2) * (1.f / D) + LN_EPS);
#pragma unroll
        for (int j = 0; j < 8; ++j) { const int col = 256 * j + 4 * lane;
            const f32x4 g = *(const GAS f32x4*)(F.ln1_g + col), bb = *(const GAS f32x4*)(F.ln1_b + col);
            const f32x4 y = v[j] * rstd * g + bb;
            { u32x2 hb; hb.x = cvt_pk_bf16(y.x, y.y); hb.y = cvt_pk_bf16(y.z, y.w); *(GAS u32x2*)(HF + (size_t)row * D + col) = hb; }
            int o = __builtin_amdgcn_cvt_pk_fp8_f32(y.x, y.y, 0, false); o = __builtin_amdgcn_cvt_pk_fp8_f32(y.z, y.w, o, true);
            *(GAS int*)(HB + tiled8_idx(NTOK, row, col)) = o;
            *(LAS f32x4*)(HT + tl * 2052 + col) = y; }
    }
    LDS_WAIT(); __syncthreads();
    {
        const int tk = lane & 15, kq = lane >> 4;
        f32x4 a0 = (f32x4){0.f, 0.f, 0.f, 0.f}, a1 = a0;
        f32x4 ws0[8], ws1[8];
#pragma unroll
        for (int kg = 0; kg < 8; ++kg) { const int k0 = 256 * w + 16 * (kg + 8) + 4 * kq; ws0[kg] = *(const GAS f32x4*)(WRT + (size_t)tk * D + k0); ws1[kg] = *(const GAS f32x4*)(WRT + (size_t)(tk + 16) * D + k0); }
#pragma unroll
        for (int kg = 0; kg < 16; ++kg) { const int k0 = 256 * w + 16 * kg + 4 * kq;
            const f32x4 hv = *(const LAS f32x4*)(HT + tk * 2052 + k0);
            const f32x4 w0 = (kg < 8) ? wr0[kg & 7] : ws0[kg & 7], w1 = (kg < 8) ? wr1[kg & 7] : ws1[kg & 7];
#pragma unroll
            for (int i = 0; i < 4; ++i) { a0 = __builtin_amdgcn_mfma_f32_16x16x4f32(hv[i], w0[i], a0, 0, 0, 0); a1 = __builtin_amdgcn_mfma_f32_16x16x4f32(hv[i], w1[i], a1, 0, 0, 0); } }
#pragma unroll
        for (int r = 0; r < 4; ++r) { RED[(w * 16 + 4 * kq + r) * 32 + tk] = a0[r]; RED[(w * 16 + 4 * kq + r) * 32 + 16 + tk] = a1[r]; }
    }
    LDS_WAIT(); __syncthreads();
    { const int t = F.tid >> 5, e = F.tid & 31; float sum = brt;
#pragma unroll
        for (int ww = 0; ww < 8; ++ww) sum += RED[(ww * 16 + t) * 32 + e];
        LG[t * 32 + e] = sum; }
    LDS_WAIT(); __syncthreads();
    LAS unsigned* LC = (LAS unsigned*)(F.lds + 131328 + 16384 + 2048);
    if (F.tid < 32) LC[F.tid] = 0u;
    LDS_WAIT(); __syncthreads();
    int ti[4] = {0, 0, 0, 0}; int ls[4] = {0, 0, 0, 0}; float gt[4] = {0.f, 0.f, 0.f, 0.f};
    if (F.tid < 16) {
        float lv[32];
#pragma unroll
        for (int e = 0; e < 32; ++e) lv[e] = LG[F.tid * 32 + e];
        float tv[4];
#pragma unroll
        for (int k = 0; k < 4; ++k) { float best = -3.0e38f; int bi = 0;
#pragma unroll
            for (int e = 0; e < 32; ++e) { const bool taken = (k > 0 && ti[0] == e) || (k > 1 && ti[1] == e) || (k > 2 && ti[2] == e); if (!taken && lv[e] > best) { best = lv[e]; bi = e; } }
            tv[k] = best; ti[k] = bi; }
        const float e1 = __expf(tv[1] - tv[0]), e2 = __expf(tv[2] - tv[0]), e3 = __expf(tv[3] - tv[0]);
        const float inv = 1.0f / (1.0f + e1 + e2 + e3);
        gt[0] = inv; gt[1] = e1 * inv; gt[2] = e2 * inv; gt[3] = e3 * inv;
#pragma unroll
        for (int k = 0; k < 4; ++k) ls[k] = (int)__hip_atomic_fetch_add(LC + ti[k], 1u, __ATOMIC_RELAXED, __HIP_MEMORY_SCOPE_WORKGROUP);
    }
    LDS_WAIT(); __syncthreads();
    if (F.tid < 32) { const unsigned c = LC[F.tid]; unsigned base = 0u; if (c) base = atomicAdd(F.ctl + CW_CNT + 64 * F.tid, c); LC[32 + F.tid] = base; }
    LDS_WAIT(); __syncthreads();
    if (F.tid < 16) {
        const int tok = tile * 16 + F.tid;
#pragma unroll
        for (int k = 0; k < 4; ++k) { const int slot = (int)LC[32 + ti[k]] + ls[k];
            ROWTOK[ti[k] * NTOK + slot] = tok; TOKE[tok * 4 + k] = ti[k]; TOKS[tok * 4 + k] = slot; TOKG[tok * 4 + k] = gt[k]; }
    }
    __syncthreads();
}

__device__ __forceinline__ void build_tile_table(Frame& F) {
    LAS int* TS = (LAS int*)(F.lds + TS_OFF);
    if (F.tid < NE) TS[40 + F.tid] = (int)__hip_atomic_load(F.ctl + CW_CNT + 64 * F.tid, __ATOMIC_RELAXED, __HIP_MEMORY_SCOPE_AGENT);
    LDS_WAIT(); __syncthreads();
    if (F.tid == 0) { int acc = 0;
        for (int e = 0; e < NE; ++e) { TS[e] = acc; acc += (TS[40 + e] + 255) >> 8; }
        TS[NE] = acc; }
    LDS_WAIT(); __syncthreads();
}
struct MoeOrder {
    LAS const int* TS; const int* ROWTOK; int G, c, NT, total; unsigned wstride; int wrow_gate_up; int i0, n, built;
    __device__ __forceinline__ bool compute(int i, pg8::Unit& u, int tsl) const {
        const int L = i * G + c; if (L >= total) return false;
        const int wg = pg8::xcd_remap(L, total);
        const int mtg = wg / NT, nt = wg - mtg * NT;
        const int e = __popcll(__ballot(tsl <= mtg) & 0xffffffffull) - 1;
        u.e = e; u.kind = mtg - TS[e]; u.row0 = 256 * mtg;
        const unsigned wb = (wrow_gate_up ? (unsigned)WS_WGU : (unsigned)WS_WD) + (unsigned)e * wstride;
        if (wrow_gate_up) { u.col0 = 128 * nt; u.b0 = wb + (unsigned)(128 * nt) * 128u; u.b1 = wb + (unsigned)(FF + 128 * nt) * 128u; }
        else { u.col0 = 256 * nt; u.b0 = wb + (unsigned)(256 * nt) * 128u; u.b1 = u.b0 + 128u * 128u; }
        u.a = wrow_gate_up ? (unsigned)WS_HB : (unsigned)WS_HH + (unsigned)(256 * mtg) * 128u;
        return true;
    }
    __device__ __forceinline__ void prep(LAS unsigned char* lds, int tid) const {
        if (built) return;
        LAS int* T = (LAS int*)(lds + AUX_TOK); LAS int* UT = (LAS int*)(lds + AUX_UT);
        const int tsl = TS[tid & 31];
        int tv[12];
#pragma unroll
        for (int i = 0; i < 12; ++i) { pg8::Unit u; u.a = 0; u.b0 = 0; u.b1 = 0; u.kind = 0; u.row0 = 0; u.col0 = 0; u.e = 0; const bool ok = compute(i, u, tsl);
            if (tid == 0) { UT[i * 8 + 0] = ok ? 1 : 0; UT[i * 8 + 1] = (int)u.a; UT[i * 8 + 2] = (int)u.b0; UT[i * 8 + 3] = (int)u.b1; UT[i * 8 + 4] = u.kind; UT[i * 8 + 5] = u.row0; UT[i * 8 + 6] = u.col0; UT[i * 8 + 7] = u.e; }
            tv[i] = 0;
            if (ok && wrow_gate_up && tid < 256) { const int cnt = TS[40 + u.e], s = 256 * u.kind + tid; if (s < cnt) tv[i] = ROWTOK[u.e * NTOK + s]; } }
        if (wrow_gate_up && tid < 256) {
#pragma unroll
            for (int i = 0; i < 12; ++i) T[i * 256 + tid] = tv[i]; }
        asm volatile("s_waitcnt vmcnt(0) lgkmcnt(0)" ::: "memory"); __syncthreads();
    }
    __device__ __forceinline__ bool next(int i, pg8::Unit& u) const {
        if (i >= n || i0 + i >= 12) return false;
        LAS const int* UT = (LAS const int*)((LAS const unsigned char*)TS - TS_OFF + AUX_UT) + (i0 + i) * 8;
        const v4i_t p = *(const LAS v4i_t*)UT, q = *(const LAS v4i_t*)(UT + 4);
        if (__builtin_amdgcn_readfirstlane(p.x) == 0) return false;
        u.a = (unsigned)__builtin_amdgcn_readfirstlane(p.y); u.b0 = (unsigned)__builtin_amdgcn_readfirstlane(p.z); u.b1 = (unsigned)__builtin_amdgcn_readfirstlane(p.w);
        u.kind = __builtin_amdgcn_readfirstlane(q.x); u.row0 = __builtin_amdgcn_readfirstlane(q.y); u.col0 = __builtin_amdgcn_readfirstlane(q.z); u.e = __builtin_amdgcn_readfirstlane(q.w);
        return true;
    }
    __device__ __forceinline__ void gather(LAS const unsigned char* tab, int i, int R0, int C0, int R1, int C1, unsigned& o00, unsigned& o01, unsigned& o10, unsigned& o11) const {
        LAS const int* T = (LAS const int*)tab + (i0 + i) * 256;
        o00 = (unsigned)(T[R0] * 128 + C0 * 2); o01 = (unsigned)(T[R1] * 128 + C1 * 2); o10 = (unsigned)(T[128 + R0] * 128 + C0 * 2); o11 = (unsigned)(T[128 + R1] * 128 + C1 * 2);
    }
};
struct EpiSwiglu {
    rsrc_t rs; const float* bp; unsigned char* wp;
    __device__ __forceinline__ void prefetch(const pg8::Unit& u, int wid, int lane, LAS unsigned char* lds, rsrc_t rs_) const { bias_prefetch(rs_, lds, wid, lane, (unsigned)WS_BGU, u.e * 2 * FF + u.col0, u.e * 2 * FF + FF + u.col0); }
    __device__ __forceinline__ void operator()(const f32x4 (&acc)[2][2][4][2], const pg8::Unit& u, int wr, int wc, int fr, int fq, LAS const unsigned char* lds) const {
        const int cr = wc * 32 + 8 * fq, lrow = wr * 64 + fr;
        f32x4 bv[2][2];
#pragma unroll
        for (int bj = 0; bj < 2; ++bj)
#pragma unroll
            for (int n = 0; n < 2; ++n) bv[bj][n] = bias_ld(lds, bj * 128 + cr + 4 * n);
        const unsigned vo = (unsigned)((((u.col0 >> 7) * HROWS + u.row0) + lrow) * 128 + cr);
#pragma unroll
        for (int ai = 0; ai < 2; ++ai)
#pragma unroll
            for (int m = 0; m < 4; ++m) {
                float o[8];
#pragma unroll
                for (int n = 0; n < 2; ++n)
#pragma unroll
                    for (int j = 0; j < 4; ++j) { const float xg = fminf(acc[ai][0][m][n][j] * (1.0f / WGU_SCALE) + bv[0][n][j], 7.0f); const float xl = fminf(fmaxf(acc[ai][1][m][n][j] * (1.0f / WGU_SCALE) + bv[1][n][j], -7.0f), 7.0f);
                        o[4 * n + j] = xg * __builtin_amdgcn_rcpf(1.0f + __builtin_amdgcn_exp2f(-1.702f * 1.4426950408889634f * xg)) * (xl + 1.0f); }
                u32x2 w; int p0 = __builtin_amdgcn_cvt_pk_fp8_f32(o[0], o[1], 0, false); p0 = __builtin_amdgcn_cvt_pk_fp8_f32(o[2], o[3], p0, true);
                int p1 = __builtin_amdgcn_cvt_pk_fp8_f32(o[4], o[5], 0, false); p1 = __builtin_amdgcn_cvt_pk_fp8_f32(o[6], o[7], p1, true); w.x = (unsigned)p0; w.y = (unsigned)p1;
                gst64(wp, w, vo, (unsigned)WS_HH + (unsigned)(ai * 128 + m * 16) * 128u); }
    }
};
struct EpiDown {
    rsrc_t rs; const float* bp; unsigned char* wp;
    __device__ __forceinline__ void prefetch(const pg8::Unit& u, int wid, int lane, LAS unsigned char* lds, rsrc_t rs_) const { bias_prefetch(rs_, lds, wid, lane, (unsigned)WS_BDN, u.e * D + u.col0, u.e * D + u.col0 + 128); }
    __device__ __forceinline__ void operator()(const f32x4 (&acc)[2][2][4][2], const pg8::Unit& u, int wr, int wc, int fr, int fq, LAS const unsigned char* lds) const {
        const int cr = wc * 32 + 8 * fq, lrow = wr * 64 + fr;
        f32x4 bv[2][2];
#pragma unroll
        for (int bj = 0; bj < 2; ++bj)
#pragma unroll
            for (int n = 0; n < 2; ++n) bv[bj][n] = bias_ld(lds, bj * 128 + cr + 4 * n) * Y_SCALE;
        const unsigned vo = (unsigned)((u.row0 + lrow) * 2048 + (u.col0 + cr));
#pragma unroll
        for (int ai = 0; ai < 2; ++ai)
#pragma unroll
            for (int m = 0; m < 4; ++m) {
#pragma unroll
                for (int bj = 0; bj < 2; ++bj) { f32x4 v0 = acc[ai][bj][m][0] * (Y_SCALE / WD_SCALE) + bv[bj][0], v1 = acc[ai][bj][m][1] * (Y_SCALE / WD_SCALE) + bv[bj][1];
#pragma unroll
                    for (int j = 0; j < 4; ++j) { v0[j] = __builtin_amdgcn_fmed3f(v0[j], -448.0f, 448.0f); v1[j] = __builtin_amdgcn_fmed3f(v1[j], -448.0f, 448.0f); }
                    u32x2 w; int p0 = __builtin_amdgcn_cvt_pk_fp8_f32(v0[0], v0[1], 0, false); p0 = __builtin_amdgcn_cvt_pk_fp8_f32(v0[2], v0[3], p0, true);
                    int p1 = __builtin_amdgcn_cvt_pk_fp8_f32(v1[0], v1[1], 0, false); p1 = __builtin_amdgcn_cvt_pk_fp8_f32(v1[2], v1[3], p1, true); w.x = (unsigned)p0; w.y = (unsigned)p1;
                    gst64(wp, w, vo, (unsigned)WS_Y + (unsigned)(ai * 128 + m * 16) * 2048u + bj * 128u); } }
    }
};

__device__ __forceinline__ void combine_row(Frame& F, int row) {
    const bf16_t* HF = (const bf16_t*)(F.ws + WS_HF); const unsigned char* Y = F.ws + WS_Y;
    const int* TOKE = (const int*)(F.ws + WS_ASSIGN); const int* TOKS = TOKE + NTOK * TOPK; const float* TOKG = (const float*)(TOKS + NTOK * TOPK);
    LAS const int* TS = (LAS const int*)(F.lds + TS_OFF);
    const int lane = F.lane;
    f32x4 v[8];
    const GAS u32x4* hr = (const GAS u32x4*)(HF + (size_t)row * D) + lane;
#pragma unroll
    for (int j = 0; j < 4; ++j) { const u32x4 hv = hr[64 * j]; v[2 * j] = (f32x4){bf_lo(hv.x), bf_hi(hv.x), bf_lo(hv.y), bf_hi(hv.y)} * DN_ALPHA; v[2 * j + 1] = (f32x4){bf_lo(hv.z), bf_hi(hv.z), bf_lo(hv.w), bf_hi(hv.w)} * DN_ALPHA; }
#pragma unroll
    for (int k = 0; k < 4; ++k) { const int e = TOKE[row * 4 + k], slot = TOKS[row * 4 + k]; const float g = TOKG[row * 4 + k] * (1.0f / Y_SCALE);
        const unsigned char* yr = Y + (size_t)(256 * TS[e] + slot) * D + 8 * lane;
#pragma unroll
        for (int j = 0; j < 4; ++j) { const u32x2 yv = *(const GAS u32x2*)(yr + 512 * j);
            const f32x2 a0 = __builtin_amdgcn_cvt_pk_f32_fp8((int)yv.x, false), a1 = __builtin_amdgcn_cvt_pk_f32_fp8((int)yv.x, true), a2 = __builtin_amdgcn_cvt_pk_f32_fp8((int)yv.y, false), a3 = __builtin_amdgcn_cvt_pk_f32_fp8((int)yv.y, true);
            v[2 * j].x += g * a0.x; v[2 * j].y += g * a0.y; v[2 * j].z += g * a1.x; v[2 * j].w += g * a1.y;
            v[2 * j + 1].x += g * a2.x; v[2 * j + 1].y += g * a2.y; v[2 * j + 1].z += g * a3.x; v[2 * j + 1].w += g * a3.y; } }
    float s = 0.f;
#pragma unroll
    for (int j = 0; j < 8; ++j) s += (v[j].x + v[j].y) + (v[j].z + v[j].w);
    const float mean = wave_sum(s) * (1.f / D); float s2 = 0.f;
#pragma unroll
    for (int j = 0; j < 8; ++j) { v[j] = v[j] - mean; s2 += (v[j].x * v[j].x + v[j].y * v[j].y) + (v[j].z * v[j].z + v[j].w * v[j].w); }
    const float rstd = 1.0f / sqrtf(wave_sum(s2) * (1.f / D) + LN_EPS);
#pragma unroll
    for (int j = 0; j < 8; ++j) { const int col = 512 * (j >> 1) + 8 * lane + 4 * (j & 1);
        const f32x4 g = *(const GAS f32x4*)(F.ln2_g + col), bb = *(const GAS f32x4*)(F.ln2_b + col);
        *(GAS f32x4*)(F.out + (size_t)row * D + col) = v[j] * rstd * g + bb; }
}

struct Args { const float* in[19]; float* out; unsigned char* ws; int ph_lo, ph_hi; };
__global__ void __launch_bounds__(512, 2) fwd_kernel(Args args) {
    extern __shared__ __attribute__((aligned(16))) unsigned char lds_raw[];
    Frame F;
    F.lds = (LAS unsigned char*)lds_raw;
    F.wave = __builtin_amdgcn_readfirstlane((int)threadIdx.x >> 6); F.lane = lane_id_opaque(); F.tid = F.wave * 64 + F.lane;
#define RETID() do { F.lane = lane_id_opaque(); F.tid = F.wave * 64 + F.lane; } while (0)
    F.xc = 0; F.xs = 0; F.G = gridDim.x; { const int bx = blockIdx.x; F.vcu = (F.G % 8 == 0) ? (bx % 8) * (F.G / 8) + bx / 8 : bx; }
    F.ws = args.ws; F.ctl = (unsigned*)(args.ws + WS_CTL); F.out = args.out;
    F.x = args.in[0]; F.w_in = args.in[1]; F.b_in = args.in[2]; F.conv_w = args.in[3]; F.conv_b = args.in[4]; F.conv_ln_g = args.in[5]; F.conv_ln_b = args.in[6];
    F.w_out = args.in[7]; F.b_out = args.in[8]; F.ln1_g = args.in[9]; F.ln1_b = args.in[10]; F.w_router = args.in[11]; F.b_router = args.in[12];
    F.w_gu = args.in[13]; F.b_gu = args.in[14]; F.w_down = args.in[15]; F.b_down = args.in[16]; F.ln2_g = args.in[17]; F.ln2_b = args.in[18];
    for (int u = (int)threadIdx.x; u < (LDS_BYTES - LDSCTL_OFF) / 4; u += 512) ((LAS unsigned*)(F.lds + LDSCTL_OFF))[u] = 0u;
    __syncthreads();
    XcdBarrier bar; bar.bar = F.ctl + CW_BAR; bar.x = 0; bar.st = nullptr;
    if (N_LAUNCHES == 1) bar = xcd_barrier_post(F.ctl + CW_BAR, (volatile LAS unsigned*)(F.lds + LDSCTL_OFF));
    const int lo = args.ph_lo, hi = args.ph_hi;
    unsigned long long tsa0 = 0, tsa1 = 0;
#define STAMP(p) do { if (PROBE_TS_A >= 0) { if (PROBE_TS_A == (p)) tsa0 = __builtin_amdgcn_s_memrealtime(); if (PROBE_TS_A + 1 == (p)) tsa1 = __builtin_amdgcn_s_memrealtime(); } } while (0)
    STAMP(0);
#define IN(k) (lo <= (k) && (k) < hi)
#define SEAM(k) do { if (IN(k) && IN((k) + 1)) xcd_barrier(bar, F.wave); STAMP((k) + 1); } while (0)
#define REPS(k) for (int rep_ = 0; rep_ < (((k) == PROBE_DUP && N_LAUNCHES == 1) ? 2 : 1); ++rep_)
#define REPBAR() do { if (rep_ == 0 && PROBE_DUP >= 0 && N_LAUNCHES == 1) xcd_barrier(bar, F.wave); } while (0)
    const __amdgpu_buffer_rsrc_t rs = __builtin_amdgcn_make_buffer_rsrc((void*)F.ws, 0, (int)WS_END, 0x00020000);

    if (IN(0)) { p0_prologue(F); SEAM(0); }

    const int NR = moe_rounds(F.G), r1 = (NR * 8) / 24, r2 = (NR * 10) / 24, r3 = (NR * 13) / 24, r4 = (NR * 16) / 24;

    if (IN(1)) {
        EpiInProj E{F.ws};
        const int g4 = F.vcu & 3;
        { InProjOrder S{F.G, (int)blockIdx.x, 0, g4}; pg8::gemm_phase<EpiInProj, InProjOrder, false, false>(F.lds, F.wave, S, E, rs, (unsigned)NTOK * 128u, (unsigned)NPROJ * 128u); }
        if (g4 < 3) { RETID(); moe_convert(F, 0, r1); }
        { InProjOrder S{F.G, (int)blockIdx.x, g4, 3}; pg8::gemm_phase<EpiInProj, InProjOrder, false, false>(F.lds, F.wave, S, E, rs, (unsigned)NTOK * 128u, (unsigned)NPROJ * 128u); }
        { InProjVtOrder S{(int)blockIdx.x}; pg8::gemm_phase<EpiInProj, InProjVtOrder, false, false>(F.lds, F.wave, S, E, rs, (unsigned)NPROJ * 128u, (unsigned)NTOK * 128u); }
        if (g4 == 3) { RETID(); moe_convert(F, 0, r1); }
        SEAM(1);
    }

    if (IN(2)) {
        const int g4 = F.vcu & 3;
        RETID(); if (g4 == 0) moe_convert(F, r1, r2);
        for (int u = F.vcu; u < 256; u += F.G) ret_unit(F, u, 0, 1);
        __syncthreads();
        RETID(); if (g4 == 1) moe_convert(F, r1, r2);
        for (int u = F.vcu; u < 256; u += F.G) ret_unit(F, u, 1, 2);
        __syncthreads();
        RETID(); if (g4 == 2) moe_convert(F, r1, r2);
        for (int u = F.vcu; u < 256; u += F.G) conv_unit(F, u);
        RETID(); if (g4 == 3) moe_convert(F, r1, r2);
        SEAM(2);
    }

    if (IN(3)) {
        const int g2 = F.vcu & 1;
        if (g2 == 0) { RETID(); moe_convert(F, r2, r3); }
        { OutProjOrder S{F.G, (int)blockIdx.x};
        EpiOutProj E{F.ws, (const unsigned char*)F.x};
        pg8::gemm_phase<EpiOutProj, OutProjOrder, false, false>(F.lds, F.wave, S, E, rs, (unsigned)NTOK * 128u, (unsigned)D * 128u); }
        if (g2 == 1) { RETID(); moe_convert(F, r2, r3); }
        SEAM(3);
    }

    if (IN(4)) {
        const int g3 = F.vcu % 3; int t = F.vcu;
        if (g3 == 0) { RETID(); moe_convert(F, r3, r4); }
        RETID(); if (t < NTOK / 16) { ln1_router_tile(F, t); t += F.G; }
        if (g3 == 1) { RETID(); moe_convert(F, r3, r4); }
        RETID(); for (; t < NTOK / 16; t += F.G) ln1_router_tile(F, t);
        if (g3 == 2) { RETID(); moe_convert(F, r3, r4); }
        SEAM(4);
    }

    if (IN(5) || IN(6) || IN(7)) { RETID(); build_tile_table(F); }

    if (IN(5)) { REPS(5) {
        LAS const int* TS = (LAS const int*)(F.lds + TS_OFF);
        EpiSwiglu E{rs, F.b_gu, F.ws};
        const int g4 = F.vcu & 3, isplit = 2 * g4;
        bool hole = false; int nex = 0;
        if (F.G == 256) { const int total = TS[NE] * 16, rem = total - ((total + 255) / 256 - 1) * 256, c = (int)blockIdx.x;
            if (rem <= 64) { hole = c < rem; if (!hole) { F.xc = c - rem; F.xs = 256 - rem; const int nx = 8 * rem; nex = (F.xc < nx) ? (nx - F.xc + F.xs - 1) / F.xs : 0; } } }
        { MoeOrder S{TS, (const int*)(F.ws + WS_ROWTOK), F.G, (int)blockIdx.x, 16, TS[NE] * 16, (unsigned)(D * 2 * FF), 1, 0, isplit, 0};
          pg8::gemm_phase<EpiSwiglu, MoeOrder, true, true>(F.lds, F.wave, S, E, rs, (unsigned)NTOK * 128u, (unsigned)(2 * FF) * 128u); }
        RETID(); if (!hole) moe_convert(F, r4, NR + nex);
        { MoeOrder S{TS, (const int*)(F.ws + WS_ROWTOK), F.G, (int)blockIdx.x, 16, TS[NE] * 16, (unsigned)(D * 2 * FF), 1, isplit, 12, 1};
          pg8::gemm_phase<EpiSwiglu, MoeOrder, true, true>(F.lds, F.wave, S, E, rs, (unsigned)NTOK * 128u, (unsigned)(2 * FF) * 128u); }
        if (PROBE_DUP == 5) REPBAR(); }
        SEAM(5);
    }

    if (IN(6)) { REPS(6) {
        LAS const int* TS = (LAS const int*)(F.lds + TS_OFF);
        MoeOrder S{TS, (const int*)(F.ws + WS_ROWTOK), F.G, (int)blockIdx.x, 8, TS[NE] * 8, (unsigned)(FF * D), 0, 0, 12, 0};
        EpiDown E{rs, F.b_down, F.ws};
        pg8::gemm_phase<EpiDown, MoeOrder, false, true>(F.lds, F.wave, S, E, rs, (unsigned)HROWS * 128u, (unsigned)D * 128u);
        if (PROBE_DUP == 6) REPBAR(); }
        SEAM(6);
    }

    if (IN(7)) { RETID(); REPS(7) {
        for (int m = F.vcu * 8 + F.wave; m < NTOK; m += F.G * 8) combine_row(F, m);
        if (PROBE_DUP == 7) REPBAR(); }
    }
    if (PROBE_TS_A >= 0) {
        xcd_barrier(bar, F.wave); STAMP(8);
        if (blockIdx.x == 0 && F.wave == 0) { const unsigned long long t0 = __builtin_amdgcn_s_memrealtime(), dt = (PROBE_TS_A == 99) ? 0ull : (tsa1 - tsa0); while (__builtin_amdgcn_s_memrealtime() - t0 < dt) __builtin_amdgcn_s_sleep(8); }
        xcd_barrier(bar, F.wave);
    }
#undef IN
#undef SEAM
}

extern "C" void kernel_launch(void* const* d_in, const int* in_sizes, int n_in, void* d_out, int out_size, void* d_ws, size_t ws_size, hipStream_t stream) {
    static int grid = 0;
    if (grid == 0) {
        if (n_in != 19 || out_size != NTOK * D || ws_size < WS_END) { fprintf(stderr, "kernel_launch: unexpected problem (n_in %d, out %d, ws %zu)\n", n_in, out_size, ws_size); grid = -1; return; }
        int dev = 0, cus = 0, per_cu = 0;
        if (hipGetDevice(&dev) != hipSuccess || hipDeviceGetAttribute(&cus, hipDeviceAttributeMultiprocessorCount, dev) != hipSuccess) { grid = -1; return; }
        if (hipFuncSetAttribute((const void*)fwd_kernel, hipFuncAttributeMaxDynamicSharedMemorySize, LDS_BYTES) != hipSuccess) { fprintf(stderr, "kernel_launch: hipFuncSetAttribute failed\n"); grid = -1; return; }
        if (hipOccupancyMaxActiveBlocksPerMultiprocessor(&per_cu, (const void*)fwd_kernel, 512, LDS_BYTES) != hipSuccess || per_cu < 1) fprintf(stderr, "kernel_launch: occupancy query says %d\n", per_cu);
        (void)hipGetLastError();
        grid = cus;
    }
    if (grid < 0) return;
    if (hipMemsetAsync((char*)d_ws + WS_CTL, 0, CTL_ZERO_BYTES, stream) != hipSuccess) return;
    Args a{};
    for (int i = 0; i < 19; ++i) a.in[i] = (const float*)d_in[i];
    a.out = (float*)d_out; a.ws = (unsigned char*)d_ws;
    if (N_LAUNCHES == 1) { a.ph_lo = 0; a.ph_hi = NPHASES; hipLaunchKernelGGL(fwd_kernel, dim3(grid), dim3(512), LDS_BYTES, stream, a); }
    else for (int p = 0; p < NPHASES; ++p) { a.ph_lo = p; a.ph_hi = p + 1; for (int r = 0; r < (p == PROBE_DUP ? 2 : 1); ++r) hipLaunchKernelGGL(fwd_kernel, dim3(grid), dim3(512), LDS_BYTES, stream, a); }
}
```
